# Optimizing an MI355X kernel written in HIP

```python
import math
import jax, jax.numpy as jnp
from jax import lax
import numpy as np

D_MODEL = 2048
BATCH = 16
SEQ = 2048
DEPTH = 1

CTX_LEN = 256
GRID_W = 64
D_MIX = D_MODEL
ATT_WIDTH = D_MIX // 2
ATT_HEADS = 8
ATT_VDIM = ATT_WIDTH // ATT_HEADS
ATT_QKDIM = ATT_VDIM // 2
MLP_WIDTH = D_MIX - ATT_WIDTH
MLP_GROUPS = 8
MLP_GDIM = MLP_WIDTH // MLP_GROUPS
CHUNK = 128
Q_BLOCK = 128
ROPE_THETA = 10000.0
EPS = 1e-6
D_IN = 4 * ATT_WIDTH + 3 * MLP_WIDTH
SPLITS = (ATT_WIDTH, 2 * ATT_WIDTH, 3 * ATT_WIDTH, 4 * ATT_WIDTH,
          4 * ATT_WIDTH + MLP_WIDTH, 4 * ATT_WIDTH + 2 * MLP_WIDTH)

kernel_name = "hymba_diffattn_chunkmlp_dit_layer"


def rmsnorm(x, g):
    xf = x.astype(jnp.float32)
    y = xf * lax.rsqrt(jnp.mean(xf * xf, axis=-1, keepdims=True) + EPS)
    return (y * g.astype(jnp.float32)).astype(x.dtype)


def layernorm(x, g, b):
    xf = x.astype(jnp.float32)
    mu = jnp.mean(xf, axis=-1, keepdims=True)
    xc = xf - mu
    var = jnp.mean(xc * xc, axis=-1, keepdims=True)
    y = xc * lax.rsqrt(var + EPS) * g.astype(jnp.float32) + b.astype(jnp.float32)
    return y.astype(x.dtype)


def lambda_init(layer_idx):
    return 0.8 - 0.6 * math.exp(-0.3 * layer_idx)


def modulation(cond, w_ada, b_ada):
    m = jax.nn.silu(cond) @ w_ada + b_ada
    return jnp.split(m, 3, axis=-1)


def axial_rope_tables(rows):
    n_freq = ATT_QKDIM // 4
    inv = ROPE_THETA ** (-jnp.arange(n_freq, dtype=jnp.float32) / n_freq)
    row = jnp.repeat(jnp.arange(rows, dtype=jnp.float32), GRID_W)
    col = jnp.tile(jnp.arange(GRID_W, dtype=jnp.float32), rows)
    ang = jnp.stack([row[:, None] * inv, col[:, None] * inv], axis=0)
    return jnp.cos(ang), jnp.sin(ang)


def apply_axial_rope(x, cos, sin):
    xf = x.astype(jnp.float32)
    half = ATT_QKDIM // 2
    quarter = half // 2
    parts = []
    for axis in range(2):
        xa = xf[..., axis * half:(axis + 1) * half]
        x1, x2 = xa[..., :quarter], xa[..., quarter:]
        cs = cos[axis][:, None, None, :]
        sn = sin[axis][:, None, None, :]
        parts += [x1 * cs - x2 * sn, x2 * cs + x1 * sn]
    return jnp.concatenate(parts, axis=-1).astype(x.dtype)


def diff_attend(q, k, v, lam):
    s = jnp.einsum('bqhmd,bkhmd->bhmqk', q, k).astype(jnp.float32) * (ATT_QKDIM ** -0.5)
    p = jax.nn.softmax(s, axis=-1)
    p = p[:, :, 0] - lam * p[:, :, 1]
    return jnp.einsum('bhqk,bkhd->bqhd', p.astype(v.dtype), v)


def diff_attend_blocked(q, k, v, lam):
    b, l = q.shape[0], q.shape[1]
    nb = l // Q_BLOCK
    qb = jnp.moveaxis(q.reshape(b, nb, Q_BLOCK, ATT_HEADS, 2, ATT_QKDIM), 1, 0)
    ob = lax.map(lambda qi: diff_attend(qi, k, v, lam), qb)
    return jnp.moveaxis(ob, 0, 1).reshape(b, l, ATT_HEADS, ATT_VDIM)


def chunk_spatial_gating(u, v_b, ln_g, ln_b, w_s, b_s):
    b, l, _ = u.shape
    vn = layernorm(v_b, ln_g, ln_b).reshape(b, l // CHUNK, CHUNK, MLP_GROUPS, MLP_GDIM)
    z = jnp.einsum('gpq,bnqgc->bnpgc', w_s, vn) + b_s.T[:, :, None]
    return u * z.reshape(b, l, MLP_WIDTH)


def merge_project(a, g_a, m, g_b, w_out):
    y = jnp.concatenate([a * jax.nn.silu(g_a), m * jax.nn.silu(g_b)], axis=-1)
    return y @ w_out


def setup_inputs(seed: int = 0) -> dict:
    key = jax.random.key(seed)
    ks = jax.random.split(key, 20)
    f = jnp.float32
    nrm = lambda k, shape, s: jax.random.normal(k, shape, f) * s
    return {
        "x": nrm(ks[0], (BATCH, SEQ, D_MODEL), 1.0),
        "c": nrm(ks[1], (BATCH, D_MODEL), 1.0),
        "ctx": nrm(ks[2], (BATCH, CTX_LEN, D_MODEL), 1.0),
        "c_ctx": nrm(ks[3], (D_MODEL,), 1.0),
        "w_ada": nrm(ks[4], (DEPTH, D_MODEL, 3 * D_MODEL), D_MODEL ** -0.5),
        "b_ada": nrm(ks[5], (DEPTH, 3 * D_MODEL), 0.01),
        "norm_g": 1.0 + nrm(ks[6], (DEPTH, D_MODEL), 0.02),
        "w_in": nrm(ks[7], (DEPTH, D_MODEL, D_IN), D_MODEL ** -0.5),
        "w_out": nrm(ks[8], (DEPTH, D_MIX, D_MODEL), D_MIX ** -0.5),
        "lam_q1": nrm(ks[9], (DEPTH, ATT_QKDIM), 0.1),
        "lam_k1": nrm(ks[10], (DEPTH, ATT_QKDIM), 0.1),
        "lam_q2": nrm(ks[11], (DEPTH, ATT_QKDIM), 0.1),
        "lam_k2": nrm(ks[12], (DEPTH, ATT_QKDIM), 0.1),
        "subln_g": 1.0 + nrm(ks[13], (DEPTH, ATT_VDIM), 0.02),
        "mlp_ln_g": 1.0 + nrm(ks[14], (DEPTH, MLP_WIDTH), 0.02),
        "mlp_ln_b": nrm(ks[15], (DEPTH, MLP_WIDTH), 0.01),
        "w_s": nrm(ks[16], (DEPTH, MLP_GROUPS, CHUNK, CHUNK), CHUNK ** -0.5),
        "b_s": 1.0 + nrm(ks[17], (DEPTH, MLP_GROUPS, CHUNK), 0.02),
        "final_g": 1.0 + nrm(ks[18], (D_MODEL,), 0.02),
    }


def reference(x, c, ctx, c_ctx, w_ada, b_ada, norm_g, w_in, w_out, lam_q1, lam_k1, lam_q2, lam_k2,
              subln_g, mlp_ln_g, mlp_ln_b, w_s, b_s, final_g):
    b, n_lat = x.shape[0], x.shape[1]
    n_ctx = ctx.shape[1]
    rows = n_lat // GRID_W
    cos, sin = axial_rope_tables(rows)
    for i in range(DEPTH):
        last = i == DEPTH - 1
        lam0 = lambda_init(i)
        lam = (jnp.exp(jnp.sum(lam_q1[i] * lam_k1[i]).astype(jnp.float32))
               - jnp.exp(jnp.sum(lam_q2[i] * lam_k2[i]).astype(jnp.float32)) + lam0)
        shift, scale, gate = modulation(c, w_ada[i], b_ada[i])
        shift_c, scale_c, gate_c = modulation(c_ctx, w_ada[i], b_ada[i])
        h = rmsnorm(x, norm_g[i]) * (1.0 + scale[:, None]) + shift[:, None]
        hc = rmsnorm(ctx, norm_g[i]) * (1.0 + scale_c) + shift_c

        q, k, v, g_a, u, v_b, g_b = jnp.split(h @ w_in[i], SPLITS, axis=-1)
        q = apply_axial_rope(q.reshape(b, n_lat, ATT_HEADS, 2, ATT_QKDIM), cos, sin)
        k = apply_axial_rope(k.reshape(b, n_lat, ATT_HEADS, 2, ATT_QKDIM), cos, sin)
        v = v.reshape(b, n_lat, ATT_HEADS, ATT_VDIM)

        if last:
            kc, vc = jnp.split(hc @ w_in[i][:, ATT_WIDTH:3 * ATT_WIDTH], 2, axis=-1)
        else:
            qc, kc, vc, g_ac, uc, v_bc, g_bc = jnp.split(hc @ w_in[i], SPLITS, axis=-1)
        kc = kc.reshape(b, n_ctx, ATT_HEADS, 2, ATT_QKDIM)
        vc = vc.reshape(b, n_ctx, ATT_HEADS, ATT_VDIM)

        k_all = jnp.concatenate([k, kc], axis=1)
        v_all = jnp.concatenate([v, vc], axis=1)
        a = diff_attend_blocked(q, k_all, v_all, lam)
        a = (rmsnorm(a, subln_g[i]) * (1.0 - lam0)).reshape(b, n_lat, ATT_WIDTH)
        m = chunk_spatial_gating(u, v_b, mlp_ln_g[i], mlp_ln_b[i], w_s[i], b_s[i])
        y = merge_project(a, g_a, m, g_b, w_out[i])

        if not last:
            qc = qc.reshape(b, n_ctx, ATT_HEADS, 2, ATT_QKDIM)
            ac = diff_attend(qc, kc, vc, lam)
            ac = (rmsnorm(ac, subln_g[i]) * (1.0 - lam0)).reshape(b, n_ctx, ATT_WIDTH)
            mc = chunk_spatial_gating(uc, v_bc, mlp_ln_g[i], mlp_ln_b[i], w_s[i], b_s[i])
            yc = merge_project(ac, g_ac, mc, g_bc, w_out[i])
            ctx = ctx + gate_c * yc
        x = x + gate[:, None] * y
    return rmsnorm(x, final_g)
```

```cpp
#include <hip/hip_runtime.h>
#include <cstdint>
#include <cstdio>

typedef unsigned short bf16_t;
typedef float f32x4 __attribute__((ext_vector_type(4)));

constexpr int NB = 16, SEQ = 2048, DM = 2048, CTX = 256, KV = SEQ + CTX;
constexpr int NLAT = NB * SEQ, NCTX = NB * CTX, MTOT = NLAT + NCTX;
constexpr int AW = 1024, NH = 8, VD = 128, QKD = 64, MW = 1024, NG = 8, GD = 128, CH = 128, DIN = 7168;
constexpr float EPS = 1e-6f, LAM0 = 0.2f, C2 = 0.125f * 1.4426950408889634f;

constexpr size_t MiB = 1u << 20;
constexpr size_t WS_CTL = 0;
constexpr size_t CTL_ZERO_BYTES = 2 * MiB;
constexpr size_t WS_ROWSS = 1 * MiB;
constexpr size_t WS_VBSTAT = 1 * MiB + 256 * 1024;
constexpr size_t WS_MOD = 2 * MiB;
constexpr size_t WS_SILU = WS_MOD + 512 * 1024;
constexpr size_t WS_ROPE = WS_SILU + 256 * 1024;
constexpr size_t WS_LAM = WS_ROPE + 16 * 1024;
constexpr size_t WS_WS = 3 * MiB;
constexpr size_t WS_WOUT = 4 * MiB;
constexpr size_t WS_WIN = 12 * MiB;
constexpr size_t WS_H = 40 * MiB;
constexpr size_t WS_Q = 184 * MiB;
constexpr size_t WS_K = 248 * MiB;
constexpr size_t WS_V = 320 * MiB;
constexpr size_t WS_GA = 392 * MiB;
constexpr size_t WS_U = 456 * MiB;
constexpr size_t WS_VB = 520 * MiB;
constexpr size_t WS_GB = 584 * MiB;
constexpr size_t WS_Y = 648 * MiB;
constexpr size_t WS_END = 776 * MiB;

__host__ __device__ __forceinline__ int perm32(int rho) { const int n = rho >> 4, i = rho & 15; return 8 * (i >> 2) + 4 * n + (i & 3); }

__device__ __forceinline__ unsigned f2bf(float f) { unsigned u = __builtin_bit_cast(unsigned, f); return (u + 0x7fffu + ((u >> 16) & 1u)) >> 16; }
__device__ __forceinline__ float bf2f(bf16_t b) { return __builtin_bit_cast(float, (unsigned)b << 16); }
__device__ __forceinline__ float silu_f(float v) { return v / (1.0f + __expf(-v)); }
__device__ __forceinline__ float wave_sum(float v) {
#pragma unroll
    for (int o = 1; o < 64; o <<= 1) v += __shfl_xor(v, o);
    return v;
}
__device__ __forceinline__ float wave_max(float v) {
#pragma unroll
    for (int o = 1; o < 64; o <<= 1) v = fmaxf(v, __shfl_xor(v, o));
    return v;
}

__global__ void n_prep(const float* c, const float* c_ctx, const float* lq1, const float* lk1, const float* lq2, const float* lk2, unsigned char* ws) {
    float* silu = (float*)(ws + WS_SILU); float* rope = (float*)(ws + WS_ROPE); float* lam = (float*)(ws + WS_LAM);
    const int tid = blockIdx.x * blockDim.x + threadIdx.x, nth = gridDim.x * blockDim.x;
    for (int i = tid; i < 17 * DM; i += nth) { const int r = i / DM, k = i % DM; const float v = r < 16 ? c[r * DM + k] : c_ctx[k]; silu[i] = silu_f(v); }
    for (int i = tid; i < 64 * 16; i += nth) { const int pos = i / 16, f = i % 16; const float inv = powf(10000.0f, -(float)f / 16.0f); const float ang = (float)pos * inv; rope[i] = cosf(ang); rope[1024 + i] = sinf(ang); }
    if (tid == 0) { float s1 = 0.f, s2 = 0.f; for (int i = 0; i < QKD; ++i) { s1 += lq1[i] * lk1[i]; s2 += lq2[i] * lk2[i]; } lam[0] = expf(s1) - expf(s2) + LAM0; }
}
__global__ void n_mod(const float* w_ada, const float* b_ada, unsigned char* ws) {
    const float* silu = (const float*)(ws + WS_SILU); float* mod = (float*)(ws + WS_MOD);
    const int j = blockIdx.x * blockDim.x + threadIdx.x; if (j >= 3 * DM) return;
    float acc[17];
#pragma unroll
    for (int r = 0; r < 17; ++r) acc[r] = 0.f;
    for (int k = 0; k < DM; ++k) { const float w = w_ada[(size_t)k * (3 * DM) + j];
#pragma unroll
        for (int r = 0; r < 17; ++r) acc[r] += silu[r * DM + k] * w; }
#pragma unroll
    for (int r = 0; r < 17; ++r) mod[r * (3 * DM) + j] = acc[r] + b_ada[j];
}
__global__ void n_transpose(const float* w, int K, int N, bf16_t* out, int perm_lim) {
    __shared__ float t[32][33];
    const int n0 = blockIdx.x * 32, k0 = blockIdx.y * 32, tx = threadIdx.x, ty = threadIdx.y;
    for (int i = 0; i < 4; ++i) t[ty + 8 * i][tx] = w[(size_t)(k0 + ty + 8 * i) * N + n0 + tx];
    __syncthreads();
    for (int i = 0; i < 4; ++i) { const int n = n0 + ty + 8 * i; const int row = (n < perm_lim) ? ((n & ~31) + perm32(n & 31)) : n;
        out[(size_t)row * K + k0 + tx] = (bf16_t)f2bf(t[tx][ty + 8 * i]); }
}
__global__ void n_cvt(const float* in, bf16_t* out, int n) { const int i = blockIdx.x * blockDim.x + threadIdx.x; if (i < n) out[i] = (bf16_t)f2bf(in[i]); }
__global__ void n_hrow(const float* x, const float* ctx, const float* norm_g, unsigned char* ws) {
    __shared__ float red[4];
    const int m = blockIdx.x; const float* mod = (const float*)(ws + WS_MOD); bf16_t* H = (bf16_t*)(ws + WS_H);
    const float* src; int r;
    if (m < NLAT) { src = x + (size_t)m * DM; r = m / SEQ; } else { src = ctx + (size_t)(m - NLAT) * DM; r = 16; }
    float v[8]; float ss = 0.f;
    for (int i = 0; i < 8; ++i) { v[i] = src[threadIdx.x + 256 * i]; ss += v[i] * v[i]; }
    ss = wave_sum(ss); if ((threadIdx.x & 63) == 0) red[threadIdx.x >> 6] = ss; __syncthreads();
    ss = red[0] + red[1] + red[2] + red[3];
    const float rs = 1.0f / sqrtf(ss * (1.0f / DM) + EPS);
    for (int i = 0; i < 8; ++i) { const int k = threadIdx.x + 256 * i; const float sh = mod[r * 6144 + k], sc = mod[r * 6144 + 2048 + k];
        const float hv = (v[i] * rs * norm_g[k]) * (1.0f + sc) + sh; H[(size_t)m * DM + k] = (bf16_t)f2bf(hv); }
}

__device__ __forceinline__ void epi1_store8(unsigned char* ws, int grow, int gcol, const float* v) {
    const int sec = gcol >> 10, cc = gcol & 1023;
    const float* rope = (const float*)(ws + WS_ROPE);
    float o[8];
    const bool lat = grow < NLAT;
    int b, t; if (lat) { b = grow / SEQ; t = grow % SEQ; } else { b = (grow - NLAT) / CTX; t = SEQ + (grow - NLAT) % CTX; }
    bf16_t* dst = nullptr;
    if (sec <= 1) {
        if (lat) { const int axis = (cc >> 5) & 1, pos = axis ? (t & 63) : (t >> 6), a = (cc & 31) >> 3;
            for (int e = 0; e < 4; ++e) { const float cs = rope[pos * 16 + 4 * a + e], sn = rope[1024 + pos * 16 + 4 * a + e]; const float x1 = v[e], x2 = v[4 + e];
                o[e] = x1 * cs - x2 * sn; o[4 + e] = x2 * cs + x1 * sn; } }
        else for (int j = 0; j < 8; ++j) o[j] = v[j];
        if (sec == 0) { if (!lat) return; for (int j = 0; j < 8; ++j) o[j] *= C2; dst = (bf16_t*)(ws + WS_Q) + (size_t)grow * AW + cc; }
        else dst = (bf16_t*)(ws + WS_K) + ((size_t)b * KV + t) * AW + cc;
    } else if (sec == 2) { for (int j = 0; j < 8; ++j) o[j] = v[j]; dst = (bf16_t*)(ws + WS_V) + ((size_t)b * KV + t) * AW + cc; }
    else { if (!lat) return;
        if (sec == 3 || sec == 6) { for (int j = 0; j < 8; ++j) o[j] = silu_f(v[j]); dst = (bf16_t*)(ws + (sec == 3 ? WS_GA : WS_GB)) + (size_t)grow * AW + cc; }
        else { for (int j = 0; j < 8; ++j) o[j] = v[j]; dst = (bf16_t*)(ws + (sec == 4 ? WS_U : WS_VB)) + (size_t)grow * AW + cc; } }
    for (int j = 0; j < 8; ++j) dst[j] = (bf16_t)f2bf(o[j]);
}

template <int MODE>
__global__ void __launch_bounds__(256) n_gemm(const bf16_t* A, const bf16_t* Bt, int K, int row_off, int col_off, unsigned char* ws, const float* x, float* out) {
    __shared__ float As[16][68]; __shared__ float Bs[16][132];
    const int tid = threadIdx.x, tx = tid & 15, ty = tid >> 4;
    const int m0 = blockIdx.y * 64, n0 = blockIdx.x * 128;
    float acc[4][8];
    for (int i = 0; i < 4; ++i) for (int j = 0; j < 8; ++j) acc[i][j] = 0.f;
    for (int k0 = 0; k0 < K; k0 += 16) {
        { const int r = tid >> 2, kk = (tid & 3) * 4; const bf16_t* p = A + (size_t)(m0 + r) * K + k0 + kk; for (int j = 0; j < 4; ++j) As[kk + j][r] = bf2f(p[j]); }
        { const int r = tid >> 1, kk = (tid & 1) * 8; const bf16_t* p = Bt + (size_t)(n0 + r) * K + k0 + kk; for (int j = 0; j < 8; ++j) Bs[kk + j][r] = bf2f(p[j]); }
        __syncthreads();
#pragma unroll
        for (int kk = 0; kk < 16; ++kk) { float a[4], b[8];
            for (int i = 0; i < 4; ++i) a[i] = As[kk][ty * 4 + i];
            for (int j = 0; j < 8; ++j) b[j] = Bs[kk][tx * 8 + j];
            for (int i = 0; i < 4; ++i) for (int j = 0; j < 8; ++j) acc[i][j] += a[i] * b[j]; }
        __syncthreads();
    }
    for (int i = 0; i < 4; ++i) { const int m = m0 + ty * 4 + i, n = n0 + tx * 8;
        if (MODE == 1) epi1_store8(ws, row_off + m, col_off + n, acc[i]);
        else { const float* mod = (const float*)(ws + WS_MOD); const int b = m / SEQ;
            for (int j = 0; j < 8; ++j) out[(size_t)m * DM + n + j] = x[(size_t)m * DM + n + j] + mod[b * 6144 + 4096 + n + j] * acc[i][j]; } }
}

__global__ void __launch_bounds__(128) n_attn(unsigned char* ws, const float* subln_g) {
    __shared__ float sc[2][2][KV]; __shared__ float qs[2][128];
    const int w = threadIdx.x >> 6, lane = threadIdx.x & 63;
    const int gq = blockIdx.x * 2 + w;
    const int t = gq % SEQ, h = (gq / SEQ) % NH, b = gq / (SEQ * NH);
    const bf16_t* Q = (const bf16_t*)(ws + WS_Q) + (size_t)(b * SEQ + t) * AW + h * 128;
    const bf16_t* Kb = (const bf16_t*)(ws + WS_K) + (size_t)b * KV * AW + h * 128;
    const bf16_t* Vb = (const bf16_t*)(ws + WS_V) + (size_t)b * KV * AW + h * 128;
    const float lam = *(const float*)(ws + WS_LAM);
    qs[w][lane] = bf2f(Q[lane]); qs[w][lane + 64] = bf2f(Q[lane + 64]);
    __syncthreads();
    float m1 = -1e30f, m2 = -1e30f;
    for (int kk = lane; kk < KV; kk += 64) { const bf16_t* kr = Kb + (size_t)kk * AW; float s1 = 0.f, s2 = 0.f;
        for (int d = 0; d < 64; ++d) { s1 += qs[w][d] * bf2f(kr[d]); s2 += qs[w][64 + d] * bf2f(kr[64 + d]); }
        sc[w][0][kk] = s1; sc[w][1][kk] = s2; m1 = fmaxf(m1, s1); m2 = fmaxf(m2, s2); }
    m1 = wave_max(m1); m2 = wave_max(m2);
    float l1 = 0.f, l2 = 0.f;
    for (int kk = lane; kk < KV; kk += 64) { const float e1 = exp2f(sc[w][0][kk] - m1), e2 = exp2f(sc[w][1][kk] - m2); sc[w][0][kk] = e1; sc[w][1][kk] = e2; l1 += e1; l2 += e2; }
    l1 = wave_sum(l1); l2 = wave_sum(l2);
    const float i1 = 1.0f / l1, i2 = lam / l2;
    for (int kk = lane; kk < KV; kk += 64) sc[w][0][kk] = sc[w][0][kk] * i1 - sc[w][1][kk] * i2;
    __syncthreads();
    float o0 = 0.f, o1 = 0.f;
    for (int kk = 0; kk < KV; ++kk) { const float p = sc[w][0][kk]; const bf16_t* vr = Vb + (size_t)kk * AW; o0 += p * bf2f(vr[lane]); o1 += p * bf2f(vr[lane + 64]); }
    const float ss = wave_sum(o0 * o0 + o1 * o1); const float rs = 1.0f / sqrtf(ss * (1.0f / 128.0f) + EPS);
    const size_t row = (size_t)(b * SEQ + t);
    const bf16_t* GA = (const bf16_t*)(ws + WS_GA) + row * AW + h * 128; bf16_t* Y = (bf16_t*)(ws + WS_Y) + row * DM + h * 128;
    Y[lane] = (bf16_t)f2bf(o0 * rs * subln_g[lane] * (1.0f - LAM0) * bf2f(GA[lane]));
    Y[lane + 64] = (bf16_t)f2bf(o1 * rs * subln_g[lane + 64] * (1.0f - LAM0) * bf2f(GA[lane + 64]));
}
__global__ void n_vbstat(unsigned char* ws) {
    const int row = blockIdx.x * 4 + (threadIdx.x >> 6), lane = threadIdx.x & 63;
    const bf16_t* vb = (const bf16_t*)(ws + WS_VB) + (size_t)row * MW; float s = 0.f, q = 0.f;
    for (int i = lane; i < MW; i += 64) { const float v = bf2f(vb[i]); s += v; q += v * v; }
    s = wave_sum(s); q = wave_sum(q);
    if (lane == 0) { float* st = (float*)(ws + WS_VBSTAT) + 2 * row; st[0] = s; st[1] = q; }
}
__global__ void __launch_bounds__(256) n_gate(unsigned char* ws, const float* ln_g, const float* ln_b, const float* w_s, const float* b_s) {
    const int ch = blockIdx.x * 256 + threadIdx.x;
    const int row = blockIdx.y;
    const int g = ch >> 7, p = row & 127, base = row & ~127;
    const bf16_t* VB = (const bf16_t*)(ws + WS_VB); const float* st = (const float*)(ws + WS_VBSTAT);
    const bf16_t* wsb = (const bf16_t*)(ws + WS_WS) + (size_t)g * CH * CH + (size_t)p * CH;
    const float lg = ln_g[ch], lb = ln_b[ch];
    float z = 0.f;
    for (int q = 0; q < CH; ++q) { const int r = base + q; const float mean = st[2 * r] * (1.0f / MW); const float var = st[2 * r + 1] * (1.0f / MW) - mean * mean; const float rstd = 1.0f / sqrtf(var + EPS);
        const float vn = bf2f((bf16_t)f2bf((bf2f(VB[(size_t)r * MW + ch]) - mean) * rstd * lg + lb));
        z += bf2f(wsb[q]) * vn; }
    z += b_s[g * CH + p];
    const float u = bf2f(((const bf16_t*)(ws + WS_U))[(size_t)row * MW + ch]), gb = bf2f(((const bf16_t*)(ws + WS_GB))[(size_t)row * MW + ch]);
    ((bf16_t*)(ws + WS_Y))[(size_t)row * DM + AW + ch] = (bf16_t)f2bf(u * z * gb);
}
__global__ void n_final(float* out, const float* final_g) {
    __shared__ float red[4];
    float* row = out + (size_t)blockIdx.x * DM; float v[8]; float ss = 0.f;
    for (int i = 0; i < 8; ++i) { v[i] = row[threadIdx.x + 256 * i]; ss += v[i] * v[i]; }
    ss = wave_sum(ss); if ((threadIdx.x & 63) == 0) red[threadIdx.x >> 6] = ss; __syncthreads();
    ss = red[0] + red[1] + red[2] + red[3]; const float rs = 1.0f / sqrtf(ss * (1.0f / DM) + EPS);
    for (int i = 0; i < 8; ++i) row[threadIdx.x + 256 * i] = v[i] * rs * final_g[threadIdx.x + 256 * i];
}

extern "C" void kernel_launch(void* const* d_in, const int* in_sizes, int n_in, void* d_out, int out_size, void* d_ws, size_t ws_size, hipStream_t stream) {
    if (n_in != 19 || ws_size < WS_END) { fprintf(stderr, "kernel_launch: unexpected n_in %d / ws %zu\n", n_in, ws_size); return; }
    const float* x = (const float*)d_in[0]; const float* c = (const float*)d_in[1]; const float* ctx = (const float*)d_in[2]; const float* c_ctx = (const float*)d_in[3];
    const float* w_ada = (const float*)d_in[4]; const float* b_ada = (const float*)d_in[5]; const float* norm_g = (const float*)d_in[6];
    const float* w_in = (const float*)d_in[7]; const float* w_out = (const float*)d_in[8];
    const float* lq1 = (const float*)d_in[9]; const float* lk1 = (const float*)d_in[10]; const float* lq2 = (const float*)d_in[11]; const float* lk2 = (const float*)d_in[12];
    const float* subln_g = (const float*)d_in[13]; const float* ln_g = (const float*)d_in[14]; const float* ln_b = (const float*)d_in[15];
    const float* w_s = (const float*)d_in[16]; const float* b_s = (const float*)d_in[17]; const float* final_g = (const float*)d_in[18];
    unsigned char* ws = (unsigned char*)d_ws; float* out = (float*)d_out;
    hipMemsetAsync(ws + WS_CTL, 0, CTL_ZERO_BYTES, stream);
    n_prep<<<64, 256, 0, stream>>>(c, c_ctx, lq1, lk1, lq2, lk2, ws);
    n_mod<<<24, 256, 0, stream>>>(w_ada, b_ada, ws);
    n_transpose<<<dim3(DIN / 32, DM / 32), dim3(32, 8), 0, stream>>>(w_in, DM, DIN, (bf16_t*)(ws + WS_WIN), 2048);
    n_transpose<<<dim3(DM / 32, DM / 32), dim3(32, 8), 0, stream>>>(w_out, DM, DM, (bf16_t*)(ws + WS_WOUT), 0);
    n_cvt<<<(NG * CH * CH + 255) / 256, 256, 0, stream>>>(w_s, (bf16_t*)(ws + WS_WS), NG * CH * CH);
    n_hrow<<<MTOT, 256, 0, stream>>>(x, ctx, norm_g, ws);
    n_gemm<1><<<dim3(DIN / 128, NLAT / 64), 256, 0, stream>>>((const bf16_t*)(ws + WS_H), (const bf16_t*)(ws + WS_WIN), DM, 0, 0, ws, nullptr, nullptr);
    n_gemm<1><<<dim3(2048 / 128, NCTX / 64), 256, 0, stream>>>((const bf16_t*)(ws + WS_H) + (size_t)NLAT * DM, (const bf16_t*)(ws + WS_WIN) + (size_t)1024 * DM, DM, NLAT, 1024, ws, nullptr, nullptr);
    n_attn<<<NB * NH * SEQ / 2, 128, 0, stream>>>(ws, subln_g);
    n_vbstat<<<NLAT / 4, 256, 0, stream>>>(ws);
    n_gate<<<dim3(4, NLAT), 256, 0, stream>>>(ws, ln_g, ln_b, w_s, b_s);
    n_gemm<2><<<dim3(DM / 128, NLAT / 64), 256, 0, stream>>>((const bf16_t*)(ws + WS_Y), (const bf16_t*)(ws + WS_WOUT), DM, 0, 0, ws, x, out);
    n_final<<<NLAT, 256, 0, stream>>>(out, final_g);
}
```

```cpp
#include <hip/hip_runtime.h>
#include <cstdint>
#include <cstdio>

typedef unsigned short bf16_t;
typedef float f32x4 __attribute__((ext_vector_type(4)));
typedef float f32x2 __attribute__((ext_vector_type(2)));
typedef float f32x16 __attribute__((ext_vector_type(16)));
typedef unsigned u32x4 __attribute__((ext_vector_type(4)));
typedef unsigned u32x2 __attribute__((ext_vector_type(2)));
typedef short bf16x8 __attribute__((ext_vector_type(8)));
typedef short s16x4 __attribute__((ext_vector_type(4)));
#define LAS __attribute__((address_space(3)))
#define GAS __attribute__((address_space(1)))

constexpr int NB = 16, SEQ = 2048, DM = 2048, CTX = 256, KV = SEQ + CTX;
constexpr int NLAT = NB * SEQ, NCTX = NB * CTX, MTOT = NLAT + NCTX;
constexpr int AW = 1024, NH = 8, VD = 128, QKD = 64, MW = 1024, NG = 8, GD = 128, CH = 128, DIN = 7168;
constexpr float EPS = 1e-6f, LAM0 = 0.2f, C2 = 0.125f * 1.4426950408889634f;

constexpr size_t MiB = 1u << 20;
constexpr size_t WS_CTL = 0;
constexpr size_t CTL_ZERO_BYTES = 2 * MiB;
constexpr size_t WS_ROWSS = 1 * MiB;
constexpr size_t WS_VBSTAT = 1 * MiB + 256 * 1024;
constexpr size_t WS_MOD = 2 * MiB;
constexpr size_t WS_SILU = WS_MOD + 512 * 1024;
constexpr size_t WS_ROPE = WS_SILU + 256 * 1024;
constexpr size_t WS_LAM = WS_ROPE + 16 * 1024;
constexpr size_t WS_WS = 3 * MiB;
constexpr size_t WS_WOUT = 4 * MiB;
constexpr size_t WS_WIN = 12 * MiB;
constexpr size_t WS_H = 40 * MiB;
constexpr size_t WS_Q = 184 * MiB;
constexpr size_t WS_K = 248 * MiB;
constexpr size_t WS_V = 320 * MiB;
constexpr size_t WS_GA = 392 * MiB;
constexpr size_t WS_U = 456 * MiB;
constexpr size_t WS_VB = 520 * MiB;
constexpr size_t WS_GB = 584 * MiB;
constexpr size_t WS_Y = 648 * MiB;
constexpr size_t WS_END = 776 * MiB;
constexpr int CW_BAR = 4096;

__host__ __device__ __forceinline__ int perm32(int rho) { const int n = rho >> 4, i = rho & 15; return 8 * (i >> 2) + 4 * n + (i & 3); }
__device__ __forceinline__ unsigned f2bf(float f) { unsigned u = __builtin_bit_cast(unsigned, f); return (u + 0x7fffu + ((u >> 16) & 1u)) >> 16; }
__device__ __forceinline__ unsigned pk2(float lo, float hi) { return f2bf(lo) | (f2bf(hi) << 16); }
typedef __bf16 bf16x2_t __attribute__((ext_vector_type(2)));
__device__ __forceinline__ unsigned cvtpk(float lo, float hi) { f32x2 v = {lo, hi}; bf16x2_t b = __builtin_convertvector(v, bf16x2_t); return __builtin_bit_cast(unsigned, b); }
__device__ __forceinline__ float bf2f(bf16_t b) { return __builtin_bit_cast(float, (unsigned)b << 16); }
__device__ __forceinline__ float bflo(unsigned w) { return __builtin_bit_cast(float, w << 16); }
__device__ __forceinline__ float bfhi(unsigned w) { return __builtin_bit_cast(float, w & 0xffff0000u); }
__device__ __forceinline__ float silu_f(float v) { return v / (1.0f + __expf(-v)); }
__device__ __forceinline__ float silu_fast(float v) { return v * __builtin_amdgcn_rcpf(1.0f + __expf(-v)); }
__device__ __forceinline__ float wave_sum(float v) {
#pragma unroll
    for (int o = 1; o < 64; o <<= 1) v += __shfl_xor(v, o);
    return v;
}
__device__ __forceinline__ float wave_max(float v) {
#pragma unroll
    for (int o = 1; o < 64; o <<= 1) v = fmaxf(v, __shfl_xor(v, o));
    return v;
}
#define LDS_WAIT() asm volatile("s_waitcnt lgkmcnt(0)" ::: "memory")
#define VM_WAIT() asm volatile("s_waitcnt vmcnt(0)" ::: "memory")
#ifndef MK_MASK
#define MK_MASK 63
#define MK_JOIN 1
#define MK_P0SUB 15
#endif
namespace pg8 {
#define PG8_LAS __attribute__((address_space(3)))
typedef unsigned short bf16_t;
typedef short bf16x8 __attribute__((ext_vector_type(8)));
typedef float f32x4 __attribute__((ext_vector_type(4)));
typedef unsigned u32x4 __attribute__((ext_vector_type(4)));
constexpr int BM = 256, BK = 64, HALF = 128, HTB = HALF * BK * 2  , STAGE_BYTES = 8 * HTB, NXCD = 8, WGM = 8;

__host__ __device__ __forceinline__ int lds_byte(int r, int c) { const int st = (r >> 4) * 2 + (c >> 5), rr = r & 15, cc = c & 31, ob = rr * 64 + cc * 2; return st * 1024 + (ob ^ (((ob >> 9) & 1) << 5)); }
__host__ __device__ __forceinline__ void stage_rc(int b, int& R, int& C) { const int st = b / 1024, sb = b % 1024, swz = sb ^ (((sb >> 9) & 1) << 5); R = (st >> 1) * 16 + swz / 64; C = (st & 1) * 32 + (swz % 64) / 2; }
__host__ __device__ __forceinline__ int perm32(int rho) { const int n = rho >> 4, i = rho & 15; return 8 * (i >> 2) + 4 * n + (i & 3); }

struct Unit { int pm, pn; };
struct Gemm { const bf16_t* A; const bf16_t* Bt; int M, N, K; };

struct StaticOrder {
    int nM, nN, nwg, G, c;
    __host__ __device__ void init(int M, int N, int G_, int c_) { nM = M / BM; nN = N / BM; nwg = nM * nN; G = G_; c = c_; }
    __host__ __device__ bool next(int i, Unit& u) const {
        const long L = (long)i * G + c; if (L >= nwg) return false;
        int wgid = (int)L; { const int q = nwg / NXCD, r = nwg % NXCD, xcd = wgid % NXCD, off = wgid / NXCD; wgid = (xcd < r ? xcd * (q + 1) : r * (q + 1) + (xcd - r) * q) + off; }
        const int nig = WGM * nN, gid = wgid / nig, fm = gid * WGM, gsz = (nM - fm) < WGM ? (nM - fm) : WGM;
        u.pm = fm + ((wgid % nig) % gsz); u.pn = (wgid % nig) / gsz; return true;
    }
    __device__ __forceinline__ void a_ready(const Unit&) const {}
    __device__ __forceinline__ void done(const Unit&) const {}
};
template <class Epi, class Sched, bool ALIGN_EPI = false, bool SP2 = false>
__device__ __forceinline__ void gemm_phase(PG8_LAS unsigned char* lds, const Gemm g, const Sched& S, const Epi& E) {
    const int tid = threadIdx.x, wid = __builtin_amdgcn_readfirstlane(tid >> 6), lane = tid & 63, wr = wid >> 2, wc = wid & 3, fr = lane & 15, fq = lane >> 4;
    const int K = g.K, nt = K / BK;
    unsigned voffA[2], voffB[2];
#pragma unroll
    for (int i = 0; i < 2; ++i) { int R, C; stage_rc(tid * 16 + i * 8192, R, C); const int Rb = Epi::PERM ? ((R & ~31) + perm32(R & 31)) : R;
        voffA[i] = (unsigned)(R * K + C) * 2u; voffB[i] = (unsigned)(Rb * K + C) * 2u; }
    const size_t kstep = (size_t)(BK * 2);
    const size_t hstep = (size_t)HALF * K * 2;
    const size_t tstep = 2 * hstep;
    const unsigned ldsw = (unsigned)wid * 1024u;
    const int aoff = lds_byte(wr * 64 + fr, fq * 8), boff = lds_byte(wc * 32 + fr, fq * 8);
#define PG8_SA(b, h) (((b) * 2 + (h)) * HTB)
#define PG8_SB(b, h) ((4 + (b) * 2 + (h)) * HTB)
#define PG8_STAGE(bufoff, gbase, voff) do { _Pragma("unroll") for (int _i = 0; _i < 2; ++_i) \
        __builtin_amdgcn_global_load_lds((const unsigned*)((const char*)(gbase) + (voff)[_i]), (PG8_LAS unsigned*)(lds + (bufoff) + ldsw + _i * 8192), 16, 0, 0); } while (0)
#define PG8_LDA(dst, b, h) do { _Pragma("unroll") for (int m = 0; m < 4; ++m) _Pragma("unroll") for (int k = 0; k < 2; ++k) dst[m][k] = *(const PG8_LAS bf16x8*)(lds + PG8_SA(b, h) + aoff + m * 2048 + k * 1024); } while (0)
#define PG8_LDB(dst, b, h) do { _Pragma("unroll") for (int n = 0; n < 2; ++n) _Pragma("unroll") for (int k = 0; k < 2; ++k) dst[n][k] = *(const PG8_LAS bf16x8*)(lds + PG8_SB(b, h) + boff + n * 2048 + k * 1024); } while (0)
#define PG8_MMA(ai, bj, At, Bt) do { __builtin_amdgcn_s_setprio(1); _Pragma("unroll") for (int m = 0; m < 4; ++m) _Pragma("unroll") for (int n = 0; n < 2; ++n) _Pragma("unroll") for (int k = 0; k < 2; ++k) \
        acc[ai][bj][m][n] = __builtin_amdgcn_mfma_f32_16x16x32_bf16(Bt[n][k], At[m][k], acc[ai][bj][m][n], 0, 0, 0); __builtin_amdgcn_s_setprio(0); } while (0)
#define PG8_WAIT_V(n) asm volatile("s_waitcnt vmcnt(" #n ")" ::: "memory")
#define PG8_WAIT_L(n) asm volatile("s_waitcnt lgkmcnt(" #n ")" ::: "memory")
#define PG8_BAR __builtin_amdgcn_s_barrier()
#define PG8_SCHED __builtin_amdgcn_sched_barrier(0)
    Unit cur, nxt; int ui = 0;
    if (!S.next(0, cur)) return;
    f32x4 acc[2][2][4][2];
#pragma unroll
    for (int a = 0; a < 2; ++a)
#pragma unroll
        for (int b = 0; b < 2; ++b)
#pragma unroll
            for (int m = 0; m < 4; ++m)
#pragma unroll
                for (int n = 0; n < 2; ++n) acc[a][b][m][n] = (f32x4){0.f, 0.f, 0.f, 0.f};
    bf16x8 At[4][2], B0[2][2], B1[2][2];
    const char* cA = (const char*)g.A + (size_t)cur.pm * tstep; const char* cB = (const char*)g.Bt + (size_t)cur.pn * tstep;
    S.a_ready(cur);
    if constexpr (SP2) {
        PG8_STAGE(PG8_SB(0, 0), cB, voffB); PG8_STAGE(PG8_SB(0, 1), cB + hstep, voffB); PG8_STAGE(PG8_SA(0, 0), cA, voffA); PG8_STAGE(PG8_SA(0, 1), cA + hstep, voffA);
        if (wr == 1) PG8_BAR;
        PG8_WAIT_V(2); PG8_BAR;
        PG8_STAGE(PG8_SB(1, 0), cB + kstep, voffB); PG8_STAGE(PG8_SA(1, 0), cA + kstep, voffA); PG8_STAGE(PG8_SB(1, 1), cB + hstep + kstep, voffB);
        PG8_WAIT_V(6); PG8_BAR;
    } else {
        PG8_STAGE(PG8_SB(0, 0), cB, voffB); PG8_STAGE(PG8_SA(0, 0), cA, voffA); PG8_STAGE(PG8_SB(0, 1), cB + hstep, voffB); PG8_STAGE(PG8_SA(0, 1), cA + hstep, voffA);
        if (wr == 1) PG8_BAR;
        PG8_WAIT_V(4); PG8_BAR;
        PG8_STAGE(PG8_SB(1, 0), cB + kstep, voffB); PG8_STAGE(PG8_SA(1, 0), cA + kstep, voffA); PG8_STAGE(PG8_SB(1, 1), cB + hstep + kstep, voffB);
        PG8_WAIT_V(6); PG8_BAR;
    }
    for (;;) {
        const bool has_next = S.next(ui + 1, nxt);
        const char* nA = has_next ? (const char*)g.A + (size_t)nxt.pm * tstep : cA; const char* nB = has_next ? (const char*)g.Bt + (size_t)nxt.pn * tstep : cB;
        for (int t = 0; t < nt; t += 2) {
            const bool last = (t == nt - 2);
            const char* a1 = cA + (size_t)(t + 1) * kstep;
            const char* a2 = last ? nA : cA + (size_t)(t + 2) * kstep; const char* b2 = last ? nB : cB + (size_t)(t + 2) * kstep;
            const char* a3 = a2 + kstep; const char* b3 = b2 + kstep;
            if (last && has_next) S.a_ready(nxt);
            if constexpr (SP2) {
            PG8_LDB(B0, 0, 0); PG8_LDB(B1, 0, 1); PG8_SCHED; PG8_LDA(At, 0, 0); PG8_STAGE(PG8_SA(1, 1), a1 + hstep, voffA);
            PG8_WAIT_V(8); PG8_WAIT_L(0); PG8_BAR; PG8_MMA(0, 0, At, B0); PG8_MMA(0, 1, At, B1); PG8_BAR; PG8_SCHED;
            PG8_LDA(At, 0, 1); PG8_STAGE(PG8_SB(0, 0), b2, voffB); PG8_STAGE(PG8_SB(0, 1), b2 + hstep, voffB); PG8_STAGE(PG8_SA(0, 0), a2, voffA);
            PG8_WAIT_V(8); PG8_WAIT_L(0); PG8_BAR; PG8_MMA(1, 0, At, B0); PG8_MMA(1, 1, At, B1); PG8_BAR; PG8_SCHED;
            PG8_LDB(B0, 1, 0); PG8_LDB(B1, 1, 1); PG8_SCHED; PG8_LDA(At, 1, 0); PG8_STAGE(PG8_SA(0, 1), a2 + hstep, voffA);
            PG8_WAIT_V(8); PG8_WAIT_L(0); PG8_BAR; PG8_MMA(0, 0, At, B0); PG8_MMA(0, 1, At, B1); PG8_BAR; PG8_SCHED;
            PG8_LDA(At, 1, 1); PG8_STAGE(PG8_SB(1, 0), b3, voffB); PG8_STAGE(PG8_SB(1, 1), b3 + hstep, voffB); PG8_STAGE(PG8_SA(1, 0), a3, voffA);
            PG8_WAIT_V(8); PG8_WAIT_L(0); PG8_BAR; PG8_MMA(1, 0, At, B0); PG8_MMA(1, 1, At, B1); PG8_BAR; PG8_SCHED;
            } else {
            PG8_LDB(B0, 0, 0); PG8_SCHED; PG8_LDA(At, 0, 0); PG8_STAGE(PG8_SA(1, 1), a1 + hstep, voffA);
            PG8_WAIT_L(8); PG8_BAR; PG8_WAIT_L(0); PG8_MMA(0, 0, At, B0); PG8_BAR; PG8_SCHED;
            PG8_LDB(B1, 0, 1); PG8_STAGE(PG8_SB(0, 0), b2, voffB);
            PG8_BAR; PG8_WAIT_L(0); PG8_MMA(0, 1, At, B1); PG8_BAR;
            PG8_LDA(At, 0, 1); PG8_STAGE(PG8_SA(0, 0), a2, voffA);
            PG8_BAR; PG8_WAIT_L(0); PG8_MMA(1, 0, At, B0); PG8_BAR; PG8_SCHED;
            PG8_STAGE(PG8_SB(0, 1), b2 + hstep, voffB);
            PG8_WAIT_V(6); PG8_BAR; PG8_MMA(1, 1, At, B1); PG8_BAR;
            PG8_LDB(B0, 1, 0); PG8_SCHED; PG8_LDA(At, 1, 0); PG8_STAGE(PG8_SA(0, 1), a2 + hstep, voffA);
            PG8_WAIT_L(8); PG8_BAR; PG8_WAIT_L(0); PG8_MMA(0, 0, At, B0); PG8_BAR; PG8_SCHED;
            PG8_LDB(B1, 1, 1); PG8_STAGE(PG8_SB(1, 0), b3, voffB);
            PG8_BAR; PG8_WAIT_L(0); PG8_MMA(0, 1, At, B1); PG8_BAR;
            PG8_LDA(At, 1, 1); PG8_STAGE(PG8_SA(1, 0), a3, voffA);
            PG8_BAR; PG8_WAIT_L(0); PG8_MMA(1, 0, At, B0); PG8_BAR; PG8_SCHED;
            PG8_STAGE(PG8_SB(1, 1), b3 + hstep, voffB);
            PG8_WAIT_V(6); PG8_BAR; PG8_MMA(1, 1, At, B1); PG8_BAR;
            }
        }
        if constexpr (ALIGN_EPI) { if (wr == 0) PG8_BAR; }
        if constexpr (!Epi::AFTER_DRAIN) { E(acc, cur, wr, wc, fr, fq); S.done(cur); }
        if (!has_next) break;
#pragma unroll
        for (int a = 0; a < 2; ++a)
#pragma unroll
            for (int b = 0; b < 2; ++b)
#pragma unroll
                for (int m = 0; m < 4; ++m)
#pragma unroll
                    for (int n = 0; n < 2; ++n) acc[a][b][m][n] = (f32x4){0.f, 0.f, 0.f, 0.f};
        cur = nxt; cA = nA; cB = nB; ++ui;
        if constexpr (ALIGN_EPI) { if (wr == 1) PG8_BAR; }
    }
    PG8_WAIT_V(0);
    if constexpr (!ALIGN_EPI) { if (wr == 0) PG8_BAR; }
    PG8_BAR;
    if constexpr (Epi::AFTER_DRAIN) { E.fused(acc, cur, wr, wc, fr, fq, lds, wid, lane); S.done(cur); }
#undef PG8_SA
#undef PG8_SB
#undef PG8_STAGE
#undef PG8_LDA
#undef PG8_LDB
#undef PG8_MMA
#undef PG8_WAIT_V
#undef PG8_WAIT_L
#undef PG8_BAR
#undef PG8_SCHED
}
}
struct Sched1 {
    int G, c;
    __device__ __forceinline__ bool next(int i, pg8::Unit& u) const {
        const int L = i * G + c; if (L >= 3712) return false;
        if (L < 3584) { const int xcd = L & 7, off = L >> 3, wgid = xcd * 448 + off, w = wgid % 224; u.pm = (wgid / 224) * 8 + (w & 7); u.pn = w >> 3; }
        else { const int l = L - 3584, xcd = l & 7, off = l >> 3; u.pm = 128 + xcd * 2 + (off & 1); u.pn = 4 + (off >> 1); }
        return true;
    }
    __device__ __forceinline__ void a_ready(const pg8::Unit&) const {}
    __device__ __forceinline__ void done(const pg8::Unit&) const {}
};
struct Epi1 {
    static constexpr bool PERM = true, AFTER_DRAIN = false;
    unsigned char* ws;
    __device__ __forceinline__ void operator()(const f32x4 (&acc)[2][2][4][2], const pg8::Unit& u, int wr, int wc, int fr, int fq) const {
        const int sec = u.pn >> 2, cc = (u.pn & 3) * 256 + wc * 32 + 8 * fq;
        const bool lat = u.pm < 128;
        const int rloc = wr * 64 + fr;
        bf16_t* base; size_t rbase;
        if (lat) { const int grow0 = u.pm * 256 + rloc; const int b = u.pm >> 3;
            if (sec == 1 || sec == 2) rbase = (size_t)grow0 + (size_t)b * CTX; else rbase = (size_t)grow0; }
        else { const int b = u.pm - 128; rbase = (size_t)b * KV + SEQ + rloc; }
        switch (sec) { case 0: base = (bf16_t*)(ws + WS_Q); break; case 1: base = (bf16_t*)(ws + WS_K); break; case 2: base = (bf16_t*)(ws + WS_V); break;
                       case 3: base = (bf16_t*)(ws + WS_GA); break; case 4: base = (bf16_t*)(ws + WS_U); break; case 5: base = (bf16_t*)(ws + WS_VB); break; default: base = (bf16_t*)(ws + WS_GB); break; }
        const float* rope = (const float*)(ws + WS_ROPE);
        const bool do_rope = lat && sec <= 1; const float qs = (sec == 0) ? C2 : 1.0f;
        const int axis = wc & 1;
#pragma unroll
        for (int ai = 0; ai < 2; ++ai)
#pragma unroll
            for (int m = 0; m < 4; ++m) {
                const int rr = ai * 128 + m * 16;
                bf16_t* rowp = base + (rbase + rr) * AW + cc;
                f32x4 cs = {1.f, 1.f, 1.f, 1.f}, sn = {0.f, 0.f, 0.f, 0.f};
                if (do_rope) { const int t = (u.pm * 256 + rloc + rr) & (SEQ - 1); const int pos = axis ? (t & 63) : (t >> 6);
                    cs = *(const f32x4*)(rope + pos * 16 + 4 * fq); sn = *(const f32x4*)(rope + 1024 + pos * 16 + 4 * fq); }
                float s1 = 0.f, s2 = 0.f;
#pragma unroll
                for (int bj = 0; bj < 2; ++bj) {
                    f32x4 v0 = acc[ai][bj][m][0], v1 = acc[ai][bj][m][1];
                    if (sec <= 1) { const f32x4 o0 = (v0 * cs - v1 * sn) * qs, o1 = (v1 * cs + v0 * sn) * qs; v0 = o0; v1 = o1; }
                    else if (sec == 3 || sec == 6) {
#pragma unroll
                        for (int e = 0; e < 4; ++e) { v0[e] = silu_fast(v0[e]); v1[e] = silu_fast(v1[e]); } }
                    else if (sec == 5) {
#pragma unroll
                        for (int e = 0; e < 4; ++e) { s1 += v0[e] + v1[e]; s2 += v0[e] * v0[e] + v1[e] * v1[e]; } }
                    u32x4 w; w.x = cvtpk(v0[0], v0[1]); w.y = cvtpk(v0[2], v0[3]); w.z = cvtpk(v1[0], v1[1]); w.w = cvtpk(v1[2], v1[3]);
                    *(u32x4*)(rowp + bj * 128) = w;
                }
                if (sec == 5) { s1 += __shfl_xor(s1, 16); s1 += __shfl_xor(s1, 32); s2 += __shfl_xor(s2, 16); s2 += __shfl_xor(s2, 32);
                    if (fq == 0) { float* st = (float*)(ws + WS_VBSTAT) + 2 * (size_t)(u.pm * 256 + rloc + rr); atomicAdd(st, s1); atomicAdd(st + 1, s2); } }
            }
    }
};
struct Epi2 {
    static constexpr bool PERM = false, AFTER_DRAIN = false;
    unsigned char* ws; const float* x; float* out;
    __device__ __forceinline__ void operator()(const f32x4 (&acc)[2][2][4][2], const pg8::Unit& u, int wr, int wc, int fr, int fq) const {
        const float* gate = (const float*)(ws + WS_MOD) + (size_t)(u.pm >> 3) * 6144 + 4096;
        const int col0 = u.pn * 256 + wc * 32 + 4 * fq;
        f32x4 gv[2][2];
#pragma unroll
        for (int bj = 0; bj < 2; ++bj)
#pragma unroll
            for (int n = 0; n < 2; ++n) gv[bj][n] = *(const f32x4*)(gate + col0 + bj * 128 + n * 16);
#pragma unroll
        for (int ai = 0; ai < 2; ++ai)
#pragma unroll
            for (int m = 0; m < 4; ++m) {
                const int row = u.pm * 256 + ai * 128 + wr * 64 + m * 16 + fr; const size_t off = (size_t)row * DM + col0; float ss = 0.f;
#pragma unroll
                for (int bj = 0; bj < 2; ++bj)
#pragma unroll
                    for (int n = 0; n < 2; ++n) { const f32x4 xv = *(const f32x4*)(x + off + bj * 128 + n * 16); const f32x4 o = xv + gv[bj][n] * acc[ai][bj][m][n];
                        *(f32x4*)(out + off + bj * 128 + n * 16) = o; ss += (o[0] * o[0] + o[1] * o[1]) + (o[2] * o[2] + o[3] * o[3]); }
                ss += __shfl_xor(ss, 16); ss += __shfl_xor(ss, 32);
                if (fq == 0) atomicAdd((float*)(ws + WS_ROWSS) + row, ss);
            }
    }
};
#define RLX_AGENT __ATOMIC_RELAXED, __HIP_MEMORY_SCOPE_AGENT
#define XB_TMO      128
#define XB_XCNT(j)  (256  + 64 * (j))
#define XB_XSUB(j)  (1280 + 64 * (j))
#define XB_XGEN(j)  (2304 + 64 * (j))
#define XB_TOP      3328
#define XB_TOPGEN   3392
#define XCD_BAR_WORDS 3456
#define XB_SPIN_CAP (1u << 18)

__device__ __forceinline__ unsigned xb_ld(unsigned* p)              { return __hip_atomic_load(p, __ATOMIC_RELAXED, __HIP_MEMORY_SCOPE_AGENT); }
__device__ __forceinline__ unsigned xb_add(unsigned* p, unsigned v) { return __hip_atomic_fetch_add(p, v, __ATOMIC_RELAXED, __HIP_MEMORY_SCOPE_AGENT); }
__device__ __forceinline__ unsigned xb_xcc_id() { return (unsigned)__builtin_amdgcn_s_getreg((3 << 11) | 20) & 0xFu; }
#define XB_SPIN(cond, bar) do { unsigned _sp = 0; while (cond) { __builtin_amdgcn_s_sleep(1); \
    if ((++_sp & 255u) == 0u) { if (xb_ld(&(bar)[XB_TMO])) break; if (_sp > XB_SPIN_CAP) { atomicAdd(&(bar)[XB_TMO], 1u); break; } } } } while (0)

struct XcdBarrier {
    unsigned* bar; unsigned x;
    volatile LAS unsigned* st;
};

__device__ __forceinline__ XcdBarrier xcd_barrier_post(unsigned* bar, volatile LAS unsigned* st) {
    XcdBarrier b; b.bar = bar; b.x = xb_xcc_id(); b.st = st;
    if (threadIdx.x == 0) (void)xb_add(&bar[XB_XCNT(b.x)], 1u);
    return b;
}
__device__ __forceinline__ void xcd_barrier_complete(unsigned* bar, unsigned x, unsigned& nloc, unsigned& nx) {
    const unsigned G = gridDim.x * gridDim.y * gridDim.z;
    unsigned sum, cnt, mine, sp = 0u;
    for (;;) {
        sum = 0u; cnt = 0u; mine = 0u;
#pragma unroll
        for (unsigned j = 0; j < 16; ++j) { const unsigned c = xb_ld(&bar[XB_XCNT(j)]); sum += c; cnt += (c > 0u) ? 1u : 0u; mine = (j == x) ? c : mine; }
        if (sum == G) break;
        __builtin_amdgcn_s_sleep(1);
        if ((++sp & 255u) == 0u) { if (xb_ld(&bar[XB_TMO])) break; if (sp > XB_SPIN_CAP) { atomicAdd(&bar[XB_TMO], 1u); break; } }
    }
    nloc = mine > 0u ? mine : 1u; nx = cnt > 0u ? cnt : 1u;
}

__device__ __forceinline__ void xcd_barrier(const XcdBarrier& b) {
    asm volatile("s_waitcnt vmcnt(0)" ::: "memory");
    __syncthreads();
    if (threadIdx.x == 0) {
        unsigned* bar = b.bar;
        __builtin_amdgcn_s_waitcnt(0);
        unsigned nloc = b.st[0], nx = b.st[1];
        if (nloc == 0u) { xcd_barrier_complete(bar, b.x, nloc, nx); b.st[0] = nloc; b.st[1] = nx; }
        const unsigned old = xb_add(&bar[XB_XSUB(b.x)], 1u);
        const unsigned gen = old / nloc;
        if (old + 1u == (gen + 1u) * nloc) {
            __builtin_amdgcn_fence(__ATOMIC_RELEASE, "agent");
            asm volatile("s_waitcnt vmcnt(0)" ::: "memory");
            const unsigned og = xb_add(&bar[XB_TOP], 1u);
            const unsigned tg = og / nx;
            if (og + 1u == (tg + 1u) * nx) xb_add(&bar[XB_TOPGEN], 1u);
            else XB_SPIN(xb_ld(&bar[XB_TOPGEN]) == tg, bar);
            __builtin_amdgcn_fence(__ATOMIC_ACQUIRE, "agent");
            xb_add(&bar[XB_XGEN(b.x)], 1u);
            asm volatile("s_waitcnt vmcnt(0)" ::: "memory");
        } else {
            XB_SPIN(xb_ld(&bar[XB_XGEN(b.x)]) == gen, bar);
            __builtin_amdgcn_fence(__ATOMIC_ACQUIRE, "agent");
            asm volatile("s_waitcnt vmcnt(0)" ::: "memory");
        }
    }
    __syncthreads();
}
constexpr int NWAVES = 8;
constexpr int RING_BYTES = 131072;
constexpr int MISC_OFF = 147456 - 512;
constexpr int LDS_BYTES = 147456;
struct Frame {
    LAS unsigned char* lds; volatile LAS unsigned* MISC;
    int tid, lane, wave, vcu, G;
    unsigned char* ws;
};
struct Args { const float* in[19]; float* out; unsigned char* ws; int ph_lo, ph_hi, li, pad; };

__device__ __forceinline__ void p0_transpose_item(const float* W, int K, int N, bf16_t* WT, int perm_lim, LAS float* scr, int item, int lane) {
    const int nblk = N / 32, kb = item / nblk, nb = item % nblk, k0 = 64 * kb, n0 = 32 * nb;
#pragma unroll 8
    for (int i = 0; i < 32; ++i) { const int kk = 2 * i + (lane >> 5); scr[kk * 33 + (lane & 31)] = W[(size_t)(k0 + kk) * N + n0 + (lane & 31)]; }
    LDS_WAIT(); asm volatile("" ::: "memory");
    const int c = lane & 7;
#pragma unroll
    for (int j = 0; j < 4; ++j) { const int n = (lane >> 3) + 8 * j; const LAS float* s = scr + (8 * c) * 33 + n;
        u32x4 o; o.x = pk2(s[0 * 33], s[1 * 33]); o.y = pk2(s[2 * 33], s[3 * 33]); o.z = pk2(s[4 * 33], s[5 * 33]); o.w = pk2(s[6 * 33], s[7 * 33]);
        const int row = (n0 < perm_lim) ? (n0 + perm32(n)) : (n0 + n);
        *(GAS u32x4*)(WT + (size_t)row * K + k0 + 8 * c) = o; }
    LDS_WAIT(); asm volatile("" ::: "memory");
}
__device__ __forceinline__ void p0_phase(Frame& F, const Args& A) {
    const float* c = A.in[1]; const float* c_ctx = A.in[3]; const float* w_ada = A.in[4]; const float* b_ada = A.in[5];
    const int bi = blockIdx.x, tid = F.tid, lane = F.lane, wave = F.wave;
    if (bi < 192 && (MK_P0SUB & 1)) {
        LAS float* sil = (LAS float*)F.lds;
        for (int i = tid; i < 17 * DM; i += 512) { const int r = i >> 11, k = i & 2047; const float v = r < 16 ? c[r * DM + k] : c_ctx[k]; sil[i] = silu_f(v); }
        __syncthreads();
        const int n0 = bi * 32, c4 = lane & 7, ks = lane >> 3;
        f32x4 acc[17];
#pragma unroll
        for (int r = 0; r < 17; ++r) acc[r] = (f32x4){0.f, 0.f, 0.f, 0.f};
        const float* wp = w_ada + (size_t)(wave * 256 + ks) * (3 * DM) + n0 + 4 * c4;
        for (int it = 0; it < 32; it += 4) {
            f32x4 wv[4];
#pragma unroll
            for (int j = 0; j < 4; ++j) wv[j] = *(const f32x4*)(wp + (size_t)(it + j) * 8 * (3 * DM));
#pragma unroll
            for (int j = 0; j < 4; ++j) { const int k = wave * 256 + (it + j) * 8 + ks;
#pragma unroll
                for (int r = 0; r < 17; ++r) acc[r] += wv[j] * sil[r * DM + k]; }
        }
#pragma unroll
        for (int r = 0; r < 17; ++r)
#pragma unroll
            for (int e = 0; e < 4; ++e) { float v = acc[r][e]; v += __shfl_xor(v, 8); v += __shfl_xor(v, 16); v += __shfl_xor(v, 32); acc[r][e] = v; }
        __syncthreads();
        LAS float* part = (LAS float*)F.lds;
        if (lane < 8) {
#pragma unroll
            for (int r = 0; r < 17; ++r) *(LAS f32x4*)(part + (wave * 17 + r) * 32 + 4 * lane) = acc[r]; }
        __syncthreads();
        for (int oi = tid; oi < 17 * 32; oi += 512) { const int r = oi >> 5, ci = oi & 31; float s = b_ada[n0 + ci];
#pragma unroll
            for (int w = 0; w < 8; ++w) s += part[(w * 17 + r) * 32 + ci];
            ((float*)(F.ws + WS_MOD))[r * (3 * DM) + n0 + ci] = s; }
        __syncthreads();
    }
    if (bi == F.G - 1 && (MK_P0SUB & 2)) {
        float* rope = (float*)(F.ws + WS_ROPE);
        for (int i = tid; i < 1024; i += 512) { const int pos = i >> 4, f = i & 15; const float inv = powf(10000.0f, -(float)f / 16.0f); const float ang = (float)pos * inv; rope[i] = cosf(ang); rope[1024 + i] = sinf(ang); }
        if (wave == 0) { const float s1 = wave_sum(A.in[9][lane] * A.in[10][lane]), s2 = wave_sum(A.in[11][lane] * A.in[12][lane]); if (lane == 0) *(float*)(F.ws + WS_LAM) = expf(s1) - expf(s2) + LAM0; }
    }
    if (MK_P0SUB & 4) for (int i = bi * 512 + tid; i < NG * CH * CH; i += F.G * 512) ((bf16_t*)(F.ws + WS_WS))[i] = (bf16_t)f2bf(A.in[16][i]);
    LAS float* scr = (LAS float*)(F.lds + wave * 16384);
    const int gw = bi * NWAVES + wave, NGW = F.G * NWAVES;
    constexpr int I_IN = (DM / 64) * (DIN / 32), I_OUT = (DM / 64) * (DM / 32);
    if (MK_P0SUB & 8) for (int it = gw; it < I_IN + I_OUT; it += NGW) {
        if (it < I_IN) p0_transpose_item(A.in[7], DM, DIN, (bf16_t*)(F.ws + WS_WIN), 2048, scr, it, lane);
        else p0_transpose_item(A.in[8], DM, DM, (bf16_t*)(F.ws + WS_WOUT), 0, scr, it - I_IN, lane);
    }
}
__device__ __forceinline__ void p1_rows(const float* src, bf16_t* dst, int nrows, const f32x4 (&sc)[4][2], const f32x4 (&sh)[4][2], int lane) {
    for (int r = 0; r < nrows; ++r) {
        const float* xr = src + (size_t)r * DM + 8 * lane; f32x4 v[4][2]; float ss = 0.f;
#pragma unroll
        for (int j = 0; j < 4; ++j)
#pragma unroll
            for (int q = 0; q < 2; ++q) { v[j][q] = *(const f32x4*)(xr + 512 * j + 4 * q); ss += (v[j][q][0] * v[j][q][0] + v[j][q][1] * v[j][q][1]) + (v[j][q][2] * v[j][q][2] + v[j][q][3] * v[j][q][3]); }
        const float rs = 1.0f / sqrtf(wave_sum(ss) * (1.0f / DM) + EPS);
#pragma unroll
        for (int j = 0; j < 4; ++j) { const f32x4 a = v[j][0] * rs * sc[j][0] + sh[j][0], b = v[j][1] * rs * sc[j][1] + sh[j][1];
            u32x4 w; w.x = cvtpk(a[0], a[1]); w.y = cvtpk(a[2], a[3]); w.z = cvtpk(b[0], b[1]); w.w = cvtpk(b[2], b[3]);
            *(u32x4*)(dst + (size_t)r * DM + 512 * j + 8 * lane) = w; }
    }
}
__device__ __forceinline__ void p1_phase(Frame& F, const Args& A) {
    const int gw = blockIdx.x * NWAVES + F.wave, NGW = F.G * NWAVES, lane = F.lane;
    const float* mod = (const float*)(F.ws + WS_MOD); const float* ng = A.in[6]; bf16_t* H = (bf16_t*)(F.ws + WS_H);
    for (int blk = gw; blk < 2048; blk += NGW) {
        f32x4 sc[4][2], sh[4][2];
        const int b = blk >> 7;
#pragma unroll
        for (int j = 0; j < 4; ++j)
#pragma unroll
            for (int q = 0; q < 2; ++q) { const int k = 512 * j + 8 * lane + 4 * q; sc[j][q] = *(const f32x4*)(ng + k) * (*(const f32x4*)(mod + b * 6144 + 2048 + k) + 1.0f); sh[j][q] = *(const f32x4*)(mod + b * 6144 + k); }
        p1_rows(A.in[0] + (size_t)blk * 16 * DM, H + (size_t)blk * 16 * DM, 16, sc, sh, lane);
#pragma unroll
        for (int j = 0; j < 4; ++j)
#pragma unroll
            for (int q = 0; q < 2; ++q) { const int k = 512 * j + 8 * lane + 4 * q; sc[j][q] = *(const f32x4*)(ng + k) * (*(const f32x4*)(mod + 16 * 6144 + 2048 + k) + 1.0f); sh[j][q] = *(const f32x4*)(mod + 16 * 6144 + k); }
        p1_rows(A.in[2] + (size_t)blk * 2 * DM, H + (size_t)(NLAT + blk * 2) * DM, 2, sc, sh, lane);
    }
}
__device__ __forceinline__ void p5_phase(Frame& F, const Args& A) {
    const int gw = blockIdx.x * NWAVES + F.wave, NGW = F.G * NWAVES, lane = F.lane;
    const float* fg = A.in[18]; const float* rowss = (const float*)(F.ws + WS_ROWSS);
    f32x4 g[4][2];
#pragma unroll
    for (int j = 0; j < 4; ++j)
#pragma unroll
        for (int q = 0; q < 2; ++q) g[j][q] = *(const f32x4*)(fg + 512 * j + 8 * lane + 4 * q);
    for (int blk = gw; blk < 2048; blk += NGW)
        for (int r = 0; r < 16; ++r) { const int row = blk * 16 + r; float* o = A.out + (size_t)row * DM + 8 * lane;
            const float rs = 1.0f / sqrtf(__hip_atomic_load(rowss + row, __ATOMIC_RELAXED, __HIP_MEMORY_SCOPE_AGENT) * (1.0f / DM) + EPS);
            f32x4 v[4][2];
#pragma unroll
            for (int j = 0; j < 4; ++j)
#pragma unroll
                for (int q = 0; q < 2; ++q) v[j][q] = *(const f32x4*)(o + 512 * j + 4 * q);
#pragma unroll
            for (int j = 0; j < 4; ++j)
#pragma unroll
                for (int q = 0; q < 2; ++q) *(f32x4*)(o + 512 * j + 4 * q) = v[j][q] * rs * g[j][q]; }
}
namespace att {
constexpr int KCS = 1040, KMS = 8 * KCS, VQS = 4160, VOFF = 2 * KMS, BUFB = VOFF + 4 * VQS;
constexpr int WSF_OFF = 2 * BUFB, ATT_LDS = WSF_OFF + 8 * 256;
constexpr float THR = 8.0f;
__device__ __forceinline__ int crow(int r, int hi) { return (r & 3) + 8 * (r >> 2) + 4 * hi; }
__device__ __forceinline__ s16x4 vtr(const LAS unsigned char* p) { return __builtin_bit_cast(s16x4, __builtin_amdgcn_ds_read_tr16_b64_v4i16((LAS s16x4*)p)); }

__device__ __forceinline__ void attn_unit(Frame& F, int unit, const float* subln_g) {
    const int tid = F.tid, lane = F.lane, wave = F.wave, r32 = lane & 31, hi = lane >> 5, map = wave >> 2, qb = wave & 3;
    const int bh = unit >> 4, b = bh >> 3, h = bh & 7, q0 = (unit & 15) * 128;
    LAS unsigned char* lds = F.lds;
    const bf16_t* Qp = (const bf16_t*)(F.ws + WS_Q) + (size_t)(b * SEQ + q0 + qb * 32 + r32) * AW + h * 128 + map * 64 + hi * 8;
    const bf16_t* Kb = (const bf16_t*)(F.ws + WS_K) + (size_t)b * KV * AW + h * 128;
    const bf16_t* Vb = (const bf16_t*)(F.ws + WS_V) + (size_t)b * KV * AW + h * 128;
    bf16x8 qr[4];
#pragma unroll
    for (int d0 = 0; d0 < 4; ++d0) qr[d0] = *(const bf16x8*)(Qp + d0 * 16);
    int koff[2], voff[2]; size_t goff[2];
#pragma unroll
    for (int i = 0; i < 2; ++i) { const int id = tid + 512 * i, key = id >> 4, ck = id & 15;
        goff[i] = (size_t)key * AW + ck * 8; koff[i] = (ck >> 3) * KMS + (ck & 7) * KCS + key * 16; voff[i] = VOFF + (ck >> 2) * VQS + key * 64 + (ck & 3) * 16; }
    u32x4 kreg[2], vreg[2];
#define ATT_LOAD(t) do { _Pragma("unroll") for (int i_ = 0; i_ < 2; ++i_) { kreg[i_] = *(const u32x4*)(Kb + (size_t)(t) * 64 * AW + goff[i_]); vreg[i_] = *(const u32x4*)(Vb + (size_t)(t) * 64 * AW + goff[i_]); } } while (0)
#define ATT_WRITE(buf) do { _Pragma("unroll") for (int i_ = 0; i_ < 2; ++i_) { *(LAS u32x4*)(lds + (buf) * BUFB + koff[i_]) = kreg[i_]; *(LAS u32x4*)(lds + (buf) * BUFB + voff[i_]) = vreg[i_]; } } while (0)
    LAS float* wsf = (LAS float*)(lds + WSF_OFF) + wave * 64;
    const int kfo = map * KMS + hi * KCS + r32 * 16;
    const int vfo = VOFF + (4 * hi + ((lane & 15) >> 2)) * 64 + ((lane >> 4) & 1) * 32 + (lane & 3) * 8;
    f32x16 o[4];
#pragma unroll
    for (int d = 0; d < 4; ++d) o[d] = (f32x16){};
    float mhat = 0.f, l_reg = 0.f;
    ATT_LOAD(0); ATT_WRITE(0); __syncthreads();
    for (int t = 0; t < KV / 64; ++t) {
        const int buf = t & 1;
        if (t + 1 < KV / 64) ATT_LOAD(t + 1);
        f32x16 p0, p1;
#pragma unroll
        for (int r = 0; r < 16; ++r) { p0[r] = -mhat; p1[r] = -mhat; }
        const LAS unsigned char* kp = lds + buf * BUFB + kfo;
#pragma unroll
        for (int d0 = 0; d0 < 4; ++d0) { const bf16x8 a0 = *(const LAS bf16x8*)(kp + 2 * d0 * KCS), a1 = *(const LAS bf16x8*)(kp + 2 * d0 * KCS + 512);
            p0 = __builtin_amdgcn_mfma_f32_32x32x16_bf16(a0, qr[d0], p0, 0, 0, 0); p1 = __builtin_amdgcn_mfma_f32_32x32x16_bf16(a1, qr[d0], p1, 0, 0, 0); }
        float rm = fmaxf(p0[0], p1[0]);
#pragma unroll
        for (int r = 1; r < 16; ++r) rm = fmaxf(rm, fmaxf(p0[r], p1[r]));
        { auto rr = __builtin_amdgcn_permlane32_swap(__float_as_uint(rm), __float_as_uint(rm), false, false); rm = fmaxf(__uint_as_float(rr[0]), __uint_as_float(rr[1])); }
        bool resc = false;
        if (t == 0 || __any(rm > THR)) {
            const float dl = (t == 0) ? rm : fmaxf(rm, 0.f); mhat += dl;
#pragma unroll
            for (int r = 0; r < 16; ++r) { p0[r] -= dl; p1[r] -= dl; }
            const float f = (t == 0) ? 1.0f : __builtin_amdgcn_exp2f(-dl); l_reg *= f; if (hi == 0) wsf[r32] = f; resc = (t != 0);
        }
        float sacc = 0.f;
#pragma unroll
        for (int r = 0; r < 16; ++r) { p0[r] = __builtin_amdgcn_exp2f(p0[r]); p1[r] = __builtin_amdgcn_exp2f(p1[r]); sacc += p0[r] + p1[r]; }
        l_reg += sacc;
        u32x4 pw[4];
#pragma unroll
        for (int i = 0; i < 4; ++i) { pw[0][i] = cvtpk(p0[2 * i], p0[2 * i + 1]); pw[1][i] = cvtpk(p0[8 + 2 * i], p0[8 + 2 * i + 1]); pw[2][i] = cvtpk(p1[2 * i], p1[2 * i + 1]); pw[3][i] = cvtpk(p1[8 + 2 * i], p1[8 + 2 * i + 1]); }
        if (resc) {
#pragma unroll
            for (int r = 0; r < 16; ++r) { const float f = wsf[crow(r, hi)];
#pragma unroll
                for (int d = 0; d < 4; ++d) o[d][r] *= f; } }
        const LAS unsigned char* vp = lds + buf * BUFB + vfo;
#pragma unroll
        for (int d = 0; d < 4; ++d)
#pragma unroll
            for (int ks = 0; ks < 4; ++ks) { const s16x4 lo = vtr(vp + d * VQS + ks * 1024), hh = vtr(vp + d * VQS + ks * 1024 + 512);
                const bf16x8 vf = (bf16x8){lo[0], lo[1], lo[2], lo[3], hh[0], hh[1], hh[2], hh[3]};
                o[d] = __builtin_amdgcn_mfma_f32_32x32x16_bf16(__builtin_bit_cast(bf16x8, pw[ks]), vf, o[d], 0, 0, 0); }
        if (t + 1 < KV / 64) ATT_WRITE(buf ^ 1);
        __syncthreads();
    }
#undef ATT_LOAD
#undef ATT_WRITE
    { auto rr = __builtin_amdgcn_permlane32_swap(__float_as_uint(l_reg), __float_as_uint(l_reg), false, false); l_reg = __uint_as_float(rr[0]) + __uint_as_float(rr[1]); }
    if (hi == 0) wsf[32 + r32] = l_reg;
    const float lam = *(const float*)(F.ws + WS_LAM);
    float rli[16];
#pragma unroll
    for (int r = 0; r < 16; ++r) rli[r] = __builtin_amdgcn_rcpf(wsf[32 + crow(r, hi)]) * (map ? lam : 1.0f);
#pragma unroll
    for (int d = 0; d < 4; ++d)
#pragma unroll
        for (int r = 0; r < 16; ++r) o[d][r] *= rli[r];
    LAS float* X = (LAS float*)lds + qb * 4096;
    if (map == 1) {
#pragma unroll
        for (int d = 0; d < 4; ++d)
#pragma unroll
            for (int r = 0; r < 16; ++r) X[(r * 4 + d) * 64 + lane] = o[d][r]; }
    __syncthreads();
    if (map == 0) {
        float ssr[16];
#pragma unroll
        for (int r = 0; r < 16; ++r) { float s = 0.f;
#pragma unroll
            for (int d = 0; d < 4; ++d) { o[d][r] -= X[(r * 4 + d) * 64 + lane]; s += o[d][r] * o[d][r]; }
            ssr[r] = s; }
#pragma unroll
        for (int r = 0; r < 16; ++r) { float s = ssr[r]; s += __shfl_xor(s, 1); s += __shfl_xor(s, 2); s += __shfl_xor(s, 4); s += __shfl_xor(s, 8); s += __shfl_xor(s, 16);
            ssr[r] = (1.0f - LAM0) / sqrtf(s * (1.0f / 128.0f) + EPS); }
        LDS_WAIT();
#pragma unroll
        for (int d = 0; d < 4; ++d)
#pragma unroll
            for (int r = 0; r < 16; ++r) X[crow(r, hi) * 128 + d * 32 + r32] = o[d][r] * ssr[r];
        LDS_WAIT();
        const size_t row0 = (size_t)(b * SEQ + q0 + qb * 32);
        const bf16_t* GA = (const bf16_t*)(F.ws + WS_GA); bf16_t* Y = (bf16_t*)(F.ws + WS_Y);
#pragma unroll
        for (int it = 0; it < 8; ++it) { const int q = it * 4 + (lane >> 4), ck = lane & 15;
            const f32x4 a0 = *(const LAS f32x4*)(X + q * 128 + ck * 8), a1 = *(const LAS f32x4*)(X + q * 128 + ck * 8 + 4);
            const f32x4 g0 = *(const f32x4*)(subln_g + ck * 8), g1 = *(const f32x4*)(subln_g + ck * 8 + 4);
            const u32x4 ga = *(const u32x4*)(GA + (row0 + q) * AW + h * 128 + ck * 8);
            u32x4 w; w.x = cvtpk(a0[0] * g0[0] * bflo(ga.x), a0[1] * g0[1] * bfhi(ga.x)); w.y = cvtpk(a0[2] * g0[2] * bflo(ga.y), a0[3] * g0[3] * bfhi(ga.y));
            w.z = cvtpk(a1[0] * g1[0] * bflo(ga.z), a1[1] * g1[1] * bfhi(ga.z)); w.w = cvtpk(a1[2] * g1[2] * bflo(ga.w), a1[3] * g1[3] * bfhi(ga.w));
            *(u32x4*)(Y + (row0 + q) * DM + h * 128 + ck * 8) = w; }
    }
    __syncthreads();
}
}
namespace gate {
constexpr int GQS = 128 * 64 + 64, ZOFF = 4 * GQS;
__device__ __forceinline__ void gate_item(Frame& F, int item, const float* ln_g, const float* ln_b, const float* b_s) {
    const int tid = F.tid, lane = F.lane, wave = F.wave, r32 = lane & 31, hi = lane >> 5;
    const int g = item & 7, chunk = item >> 3; const size_t base = (size_t)chunk * 128;
    LAS unsigned char* lds = F.lds;
    const bf16_t* VB = (const bf16_t*)(F.ws + WS_VB); const float* st = (const float*)(F.ws + WS_VBSTAT);
#pragma unroll
    for (int i = 0; i < 4; ++i) { const int id = tid + 512 * i, row = id >> 4, ck = id & 15;
        const u32x4 v = *(const u32x4*)(VB + (base + row) * MW + g * 128 + ck * 8);
        const float s1 = __hip_atomic_load(st + 2 * (base + row), __ATOMIC_RELAXED, __HIP_MEMORY_SCOPE_AGENT), s2 = __hip_atomic_load(st + 2 * (base + row) + 1, __ATOMIC_RELAXED, __HIP_MEMORY_SCOPE_AGENT);
        const float mean = s1 * (1.0f / MW), var = s2 * (1.0f / MW) - mean * mean, rstd = 1.0f / sqrtf(var + EPS);
        const f32x4 g0 = *(const f32x4*)(ln_g + g * 128 + ck * 8), g1 = *(const f32x4*)(ln_g + g * 128 + ck * 8 + 4), b0 = *(const f32x4*)(ln_b + g * 128 + ck * 8), b1 = *(const f32x4*)(ln_b + g * 128 + ck * 8 + 4);
        u32x4 w;
        w.x = cvtpk((bflo(v.x) - mean) * rstd * g0[0] + b0[0], (bfhi(v.x) - mean) * rstd * g0[1] + b0[1]); w.y = cvtpk((bflo(v.y) - mean) * rstd * g0[2] + b0[2], (bfhi(v.y) - mean) * rstd * g0[3] + b0[3]);
        w.z = cvtpk((bflo(v.z) - mean) * rstd * g1[0] + b1[0], (bfhi(v.z) - mean) * rstd * g1[1] + b1[1]); w.w = cvtpk((bflo(v.w) - mean) * rstd * g1[2] + b1[2], (bfhi(v.w) - mean) * rstd * g1[3] + b1[3]);
        *(LAS u32x4*)(lds + (ck >> 2) * GQS + row * 64 + (ck & 3) * 16) = w; }
    const int pb = wave >> 1, ch = wave & 1;
    const bf16_t* Wp = (const bf16_t*)(F.ws + WS_WS) + (size_t)g * CH * CH + (size_t)(pb * 32 + r32) * CH + hi * 8;
    bf16x8 af[8];
#pragma unroll
    for (int ks = 0; ks < 8; ++ks) af[ks] = *(const bf16x8*)(Wp + ks * 16);
    __syncthreads();
    f32x16 z[2]; z[0] = (f32x16){}; z[1] = (f32x16){};
    const LAS unsigned char* vp = lds + (8 * hi + ((lane & 15) >> 2)) * 64 + ((lane >> 4) & 1) * 32 + (lane & 3) * 8;
#pragma unroll
    for (int j = 0; j < 2; ++j)
#pragma unroll
        for (int ks = 0; ks < 8; ++ks) { const s16x4 lo = att::vtr(vp + (2 * ch + j) * GQS + ks * 1024), hh = att::vtr(vp + (2 * ch + j) * GQS + ks * 1024 + 256);
            const bf16x8 vf = (bf16x8){lo[0], lo[1], lo[2], lo[3], hh[0], hh[1], hh[2], hh[3]};
            z[j] = __builtin_amdgcn_mfma_f32_32x32x16_bf16(af[ks], vf, z[j], 0, 0, 0); }
    LAS float* Z = (LAS float*)(lds + ZOFF);
#pragma unroll
    for (int r = 0; r < 16; ++r) { const int p = pb * 32 + att::crow(r, hi); const float bs = b_s[g * CH + p];
#pragma unroll
        for (int j = 0; j < 2; ++j) Z[p * 128 + (2 * ch + j) * 32 + r32] = z[j][r] + bs; }
    __syncthreads();
    const bf16_t* U = (const bf16_t*)(F.ws + WS_U); const bf16_t* GB = (const bf16_t*)(F.ws + WS_GB); bf16_t* Y = (bf16_t*)(F.ws + WS_Y);
#pragma unroll
    for (int i = 0; i < 4; ++i) { const int id = tid + 512 * i, row = id >> 4, ck = id & 15;
        const u32x4 u = *(const u32x4*)(U + (base + row) * MW + g * 128 + ck * 8), gb = *(const u32x4*)(GB + (base + row) * MW + g * 128 + ck * 8);
        const f32x4 z0 = *(const LAS f32x4*)(Z + row * 128 + ck * 8), z1 = *(const LAS f32x4*)(Z + row * 128 + ck * 8 + 4);
        u32x4 w; w.x = cvtpk(bflo(u.x) * z0[0] * bflo(gb.x), bfhi(u.x) * z0[1] * bfhi(gb.x)); w.y = cvtpk(bflo(u.y) * z0[2] * bflo(gb.y), bfhi(u.y) * z0[3] * bfhi(gb.y));
        w.z = cvtpk(bflo(u.z) * z1[0] * bflo(gb.z), bfhi(u.z) * z1[1] * bfhi(gb.z)); w.w = cvtpk(bflo(u.w) * z1[2] * bflo(gb.w), bfhi(u.w) * z1[3] * bfhi(gb.w));
        *(u32x4*)(Y + (base + row) * DM + AW + g * 128 + ck * 8) = w; }
    __syncthreads();
}
}
__global__ void __launch_bounds__(NWAVES * 64, 2) mega_fwd(Args args) {
    extern __shared__ __attribute__((aligned(16))) unsigned char lds_raw[];
    Frame F;
    F.lds = (LAS unsigned char*)lds_raw; F.MISC = (volatile LAS unsigned*)(F.lds + MISC_OFF);
    F.tid = threadIdx.x; F.lane = F.tid & 63; F.wave = __builtin_amdgcn_readfirstlane(F.tid >> 6);
    F.G = gridDim.x; { const int bx = blockIdx.x; F.vcu = (F.G % 8 == 0) ? (bx % 8) * (F.G / 8) + bx / 8 : bx; }
    F.ws = args.ws;
    for (int u = F.tid; u < (LDS_BYTES - MISC_OFF) / 4; u += NWAVES * 64) ((LAS unsigned*)(F.lds + MISC_OFF))[u] = 0u;
    __syncthreads();
    XcdBarrier bar = xcd_barrier_post((unsigned*)(F.ws + WS_CTL) + CW_BAR + args.li * XCD_BAR_WORDS, F.MISC + 8);
    const int lo = args.ph_lo, hi = args.ph_hi;
#define IN(k) (lo <= (k) && (k) < hi)
#define BOTH(k) (IN(k) && IN((k) + 1))
    if (IN(0)) { p0_phase(F, args); if (BOTH(0)) xcd_barrier(bar); }
    if (IN(1)) { p1_phase(F, args); if (BOTH(1)) xcd_barrier(bar); }
    if (IN(2)) {
        pg8::Gemm g{(const bf16_t*)(F.ws + WS_H), (const bf16_t*)(F.ws + WS_WIN), MTOT, DIN, DM};
        Sched1 S{F.G, (int)blockIdx.x}; Epi1 E{F.ws};
        pg8::gemm_phase<Epi1, Sched1, true, true>(F.lds, g, S, E);
        if (BOTH(2)) xcd_barrier(bar);
    }
    if (IN(3)) {
        for (int i = 0; i < 8; ++i) { const int unit = F.vcu * 8 + i; if (unit < NB * NH * 16) att::attn_unit(F, unit, args.in[13]); }
        for (int i = 0; i < 8; ++i) { const int item = F.vcu * 8 + i; if (item < 2048) gate::gate_item(F, item, args.in[14], args.in[15], args.in[17]); }
        if (BOTH(3)) xcd_barrier(bar);
    }
    if (IN(4)) {
        pg8::Gemm g{(const bf16_t*)(F.ws + WS_Y), (const bf16_t*)(F.ws + WS_WOUT), NLAT, DM, DM};
        pg8::StaticOrder S; S.init(NLAT, DM, F.G, (int)blockIdx.x); Epi2 E{F.ws, args.in[0], args.out};
        pg8::gemm_phase<Epi2, pg8::StaticOrder, true, true>(F.lds, g, S, E);
        if (BOTH(4)) xcd_barrier(bar);
    }
    if (IN(5)) p5_phase(F, args);
#undef IN
#undef BOTH
}
#if MK_MASK != 63
__global__ void n_prep(const float* c, const float* c_ctx, const float* lq1, const float* lk1, const float* lq2, const float* lk2, unsigned char* ws) {
    float* silu = (float*)(ws + WS_SILU); float* rope = (float*)(ws + WS_ROPE); float* lam = (float*)(ws + WS_LAM);
    const int tid = blockIdx.x * blockDim.x + threadIdx.x, nth = gridDim.x * blockDim.x;
    for (int i = tid; i < 17 * DM; i += nth) { const int r = i / DM, k = i % DM; const float v = r < 16 ? c[r * DM + k] : c_ctx[k]; silu[i] = silu_f(v); }
    for (int i = tid; i < 64 * 16; i += nth) { const int pos = i / 16, f = i % 16; const float inv = powf(10000.0f, -(float)f / 16.0f); const float ang = (float)pos * inv; rope[i] = cosf(ang); rope[1024 + i] = sinf(ang); }
    if (tid == 0) { float s1 = 0.f, s2 = 0.f; for (int i = 0; i < QKD; ++i) { s1 += lq1[i] * lk1[i]; s2 += lq2[i] * lk2[i]; } lam[0] = expf(s1) - expf(s2) + LAM0; }
}
__global__ void n_mod(const float* w_ada, const float* b_ada, unsigned char* ws) {
    const float* silu = (const float*)(ws + WS_SILU); float* mod = (float*)(ws + WS_MOD);
    const int j = blockIdx.x * blockDim.x + threadIdx.x; if (j >= 3 * DM) return;
    float acc[17];
#pragma unroll
    for (int r = 0; r < 17; ++r) acc[r] = 0.f;
    for (int k = 0; k < DM; ++k) { const float w = w_ada[(size_t)k * (3 * DM) + j];
#pragma unroll
        for (int r = 0; r < 17; ++r) acc[r] += silu[r * DM + k] * w; }
#pragma unroll
    for (int r = 0; r < 17; ++r) mod[r * (3 * DM) + j] = acc[r] + b_ada[j];
}
__global__ void n_transpose(const float* w, int K, int N, bf16_t* out, int perm_lim) {
    __shared__ float t[32][33];
    const int n0 = blockIdx.x * 32, k0 = blockIdx.y * 32, tx = threadIdx.x, ty = threadIdx.y;
    for (int i = 0; i < 4; ++i) t[ty + 8 * i][tx] = w[(size_t)(k0 + ty + 8 * i) * N + n0 + tx];
    __syncthreads();
    for (int i = 0; i < 4; ++i) { const int n = n0 + ty + 8 * i; const int row = (n < perm_lim) ? ((n & ~31) + perm32(n & 31)) : n;
        out[(size_t)row * K + k0 + tx] = (bf16_t)f2bf(t[tx][ty + 8 * i]); }
}
__global__ void n_cvt(const float* in, bf16_t* out, int n) { const int i = blockIdx.x * blockDim.x + threadIdx.x; if (i < n) out[i] = (bf16_t)f2bf(in[i]); }
__global__ void n_hrow(const float* x, const float* ctx, const float* norm_g, unsigned char* ws) {
    __shared__ float red[4];
    const int m = blockIdx.x; const float* mod = (const float*)(ws + WS_MOD); bf16_t* H = (bf16_t*)(ws + WS_H);
    const float* src; int r;
    if (m < NLAT) { src = x + (size_t)m * DM; r = m / SEQ; } else { src = ctx + (size_t)(m - NLAT) * DM; r = 16; }
    float v[8]; float ss = 0.f;
    for (int i = 0; i < 8; ++i) { v[i] = src[threadIdx.x + 256 * i]; ss += v[i] * v[i]; }
    ss = wave_sum(ss); if ((threadIdx.x & 63) == 0) red[threadIdx.x >> 6] = ss; __syncthreads();
    ss = red[0] + red[1] + red[2] + red[3];
    const float rs = 1.0f / sqrtf(ss * (1.0f / DM) + EPS);
    for (int i = 0; i < 8; ++i) { const int k = threadIdx.x + 256 * i; const float sh = mod[r * 6144 + k], sc = mod[r * 6144 + 2048 + k];
        const float hv = (v[i] * rs * norm_g[k]) * (1.0f + sc) + sh; H[(size_t)m * DM + k] = (bf16_t)f2bf(hv); }
}

__device__ __forceinline__ void epi1_store8(unsigned char* ws, int grow, int gcol, const float* v) {
    const int sec = gcol >> 10, cc = gcol & 1023;
    const float* rope = (const float*)(ws + WS_ROPE);
    float o[8];
    const bool lat = grow < NLAT;
    int b, t; if (lat) { b = grow / SEQ; t = grow % SEQ; } else { b = (grow - NLAT) / CTX; t = SEQ + (grow - NLAT) % CTX; }
    bf16_t* dst = nullptr;
    if (sec <= 1) {
        if (lat) { const int axis = (cc >> 5) & 1, pos = axis ? (t & 63) : (t >> 6), a = (cc & 31) >> 3;
            for (int e = 0; e < 4; ++e) { const float cs = rope[pos * 16 + 4 * a + e], sn = rope[1024 + pos * 16 + 4 * a + e]; const float x1 = v[e], x2 = v[4 + e];
                o[e] = x1 * cs - x2 * sn; o[4 + e] = x2 * cs + x1 * sn; } }
        else for (int j = 0; j < 8; ++j) o[j] = v[j];
        if (sec == 0) { if (!lat) return; for (int j = 0; j < 8; ++j) o[j] *= C2; dst = (bf16_t*)(ws + WS_Q) + (size_t)grow * AW + cc; }
        else dst = (bf16_t*)(ws + WS_K) + ((size_t)b * KV + t) * AW + cc;
    } else if (sec == 2) { for (int j = 0; j < 8; ++j) o[j] = v[j]; dst = (bf16_t*)(ws + WS_V) + ((size_t)b * KV + t) * AW + cc; }
    else { if (!lat) return;
        if (sec == 3 || sec == 6) { for (int j = 0; j < 8; ++j) o[j] = silu_f(v[j]); dst = (bf16_t*)(ws + (sec == 3 ? WS_GA : WS_GB)) + (size_t)grow * AW + cc; }
        else { for (int j = 0; j < 8; ++j) o[j] = v[j]; dst = (bf16_t*)(ws + (sec == 4 ? WS_U : WS_VB)) + (size_t)grow * AW + cc; } }
    for (int j = 0; j < 8; ++j) dst[j] = (bf16_t)f2bf(o[j]);
}

template <int MODE>
__global__ void __launch_bounds__(256) n_gemm(const bf16_t* A, const bf16_t* Bt, int K, int row_off, int col_off, unsigned char* ws, const float* x, float* out) {
    __shared__ float As[16][68]; __shared__ float Bs[16][132];
    const int tid = threadIdx.x, tx = tid & 15, ty = tid >> 4;
    const int m0 = blockIdx.y * 64, n0 = blockIdx.x * 128;
    float acc[4][8];
    for (int i = 0; i < 4; ++i) for (int j = 0; j < 8; ++j) acc[i][j] = 0.f;
    for (int k0 = 0; k0 < K; k0 += 16) {
        { const int r = tid >> 2, kk = (tid & 3) * 4; const bf16_t* p = A + (size_t)(m0 + r) * K + k0 + kk; for (int j = 0; j < 4; ++j) As[kk + j][r] = bf2f(p[j]); }
        { const int r = tid >> 1, kk = (tid & 1) * 8; const bf16_t* p = Bt + (size_t)(n0 + r) * K + k0 + kk; for (int j = 0; j < 8; ++j) Bs[kk + j][r] = bf2f(p[j]); }
        __syncthreads();
#pragma unroll
        for (int kk = 0; kk < 16; ++kk) { float a[4], b[8];
            for (int i = 0; i < 4; ++i) a[i] = As[kk][ty * 4 + i];
            for (int j = 0; j < 8; ++j) b[j] = Bs[kk][tx * 8 + j];
            for (int i = 0; i < 4; ++i) for (int j = 0; j < 8; ++j) acc[i][j] += a[i] * b[j]; }
        __syncthreads();
    }
    for (int i = 0; i < 4; ++i) { const int m = m0 + ty * 4 + i, n = n0 + tx * 8;
        if (MODE == 1) epi1_store8(ws, row_off + m, col_off + n, acc[i]);
        else { const float* mod = (const float*)(ws + WS_MOD); const int b = m / SEQ;
            for (int j = 0; j < 8; ++j) out[(size_t)m * DM + n + j] = x[(size_t)m * DM + n + j] + mod[b * 6144 + 4096 + n + j] * acc[i][j]; } }
}

__global__ void __launch_bounds__(128) n_attn(unsigned char* ws, const float* subln_g) {
    __shared__ float sc[2][2][KV]; __shared__ float qs[2][128];
    const int w = threadIdx.x >> 6, lane = threadIdx.x & 63;
    const int gq = blockIdx.x * 2 + w;
    const int t = gq % SEQ, h = (gq / SEQ) % NH, b = gq / (SEQ * NH);
    const bf16_t* Q = (const bf16_t*)(ws + WS_Q) + (size_t)(b * SEQ + t) * AW + h * 128;
    const bf16_t* Kb = (const bf16_t*)(ws + WS_K) + (size_t)b * KV * AW + h * 128;
    const bf16_t* Vb = (const bf16_t*)(ws + WS_V) + (size_t)b * KV * AW + h * 128;
    const float lam = *(const float*)(ws + WS_LAM);
    qs[w][lane] = bf2f(Q[lane]); qs[w][lane + 64] = bf2f(Q[lane + 64]);
    __syncthreads();
    float m1 = -1e30f, m2 = -1e30f;
    for (int kk = lane; kk < KV; kk += 64) { const bf16_t* kr = Kb + (size_t)kk * AW; float s1 = 0.f, s2 = 0.f;
        for (int d = 0; d < 64; ++d) { s1 += qs[w][d] * bf2f(kr[d]); s2 += qs[w][64 + d] * bf2f(kr[64 + d]); }
        sc[w][0][kk] = s1; sc[w][1][kk] = s2; m1 = fmaxf(m1, s1); m2 = fmaxf(m2, s2); }
    m1 = wave_max(m1); m2 = wave_max(m2);
    float l1 = 0.f, l2 = 0.f;
    for (int kk = lane; kk < KV; kk += 64) { const float e1 = exp2f(sc[w][0][kk] - m1), e2 = exp2f(sc[w][1][kk] - m2); sc[w][0][kk] = e1; sc[w][1][kk] = e2; l1 += e1; l2 += e2; }
    l1 = wave_sum(l1); l2 = wave_sum(l2);
    const float i1 = 1.0f / l1, i2 = lam / l2;
    for (int kk = lane; kk < KV; kk += 64) sc[w][0][kk] = sc[w][0][kk] * i1 - sc[w][1][kk] * i2;
    __syncthreads();
    float o0 = 0.f, o1 = 0.f;
    for (int kk = 0; kk < KV; ++kk) { const float p = sc[w][0][kk]; const bf16_t* vr = Vb + (size_t)kk * AW; o0 += p * bf2f(vr[lane]); o1 += p * bf2f(vr[lane + 64]); }
    const float ss = wave_sum(o0 * o0 + o1 * o1); const float rs = 1.0f / sqrtf(ss * (1.0f / 128.0f) + EPS);
    const size_t row = (size_t)(b * SEQ + t);
    const bf16_t* GA = (const bf16_t*)(ws + WS_GA) + row * AW + h * 128; bf16_t* Y = (bf16_t*)(ws + WS_Y) + row * DM + h * 128;
    Y[lane] = (bf16_t)f2bf(o0 * rs * subln_g[lane] * (1.0f - LAM0) * bf2f(GA[lane]));
    Y[lane + 64] = (bf16_t)f2bf(o1 * rs * subln_g[lane + 64] * (1.0f - LAM0) * bf2f(GA[lane + 64]));
}
__global__ void n_vbstat(unsigned char* ws) {
    const int row = blockIdx.x * 4 + (threadIdx.x >> 6), lane = threadIdx.x & 63;
    const bf16_t* vb = (const bf16_t*)(ws + WS_VB) + (size_t)row * MW; float s = 0.f, q = 0.f;
    for (int i = lane; i < MW; i += 64) { const float v = bf2f(vb[i]); s += v; q += v * v; }
    s = wave_sum(s); q = wave_sum(q);
    if (lane == 0) { float* st = (float*)(ws + WS_VBSTAT) + 2 * row; st[0] = s; st[1] = q; }
}
__global__ void __launch_bounds__(256) n_gate(unsigned char* ws, const float* ln_g, const float* ln_b, const float* w_s, const float* b_s) {
    const int ch = blockIdx.x * 256 + threadIdx.x;
    const int row = blockIdx.y;
    const int g = ch >> 7, p = row & 127, base = row & ~127;
    const bf16_t* VB = (const bf16_t*)(ws + WS_VB); const float* st = (const float*)(ws + WS_VBSTAT);
    const bf16_t* wsb = (const bf16_t*)(ws + WS_WS) + (size_t)g * CH * CH + (size_t)p * CH;
    const float lg = ln_g[ch], lb = ln_b[ch];
    float z = 0.f;
    for (int q = 0; q < CH; ++q) { const int r = base + q; const float mean = st[2 * r] * (1.0f / MW); const float var = st[2 * r + 1] * (1.0f / MW) - mean * mean; const float rstd = 1.0f / sqrtf(var + EPS);
        const float vn = bf2f((bf16_t)f2bf((bf2f(VB[(size_t)r * MW + ch]) - mean) * rstd * lg + lb));
        z += bf2f(wsb[q]) * vn; }
    z += b_s[g * CH + p];
    const float u = bf2f(((const bf16_t*)(ws + WS_U))[(size_t)row * MW + ch]), gb = bf2f(((const bf16_t*)(ws + WS_GB))[(size_t)row * MW + ch]);
    ((bf16_t*)(ws + WS_Y))[(size_t)row * DM + AW + ch] = (bf16_t)f2bf(u * z * gb);
}
__global__ void n_final(float* out, const float* final_g) {
    __shared__ float red[4];
    float* row = out + (size_t)blockIdx.x * DM; float v[8]; float ss = 0.f;
    for (int i = 0; i < 8; ++i) { v[i] = row[threadIdx.x + 256 * i]; ss += v[i] * v[i]; }
    ss = wave_sum(ss); if ((threadIdx.x & 63) == 0) red[threadIdx.x >> 6] = ss; __syncthreads();
    ss = red[0] + red[1] + red[2] + red[3]; const float rs = 1.0f / sqrtf(ss * (1.0f / DM) + EPS);
    for (int i = 0; i < 8; ++i) row[threadIdx.x + 256 * i] = v[i] * rs * final_g[threadIdx.x + 256 * i];
}

#endif
static void launch_mega(const Args& a0, int lo, int hi, int li, int grid, hipStream_t stream) {
    Args a = a0; a.ph_lo = lo; a.ph_hi = hi; a.li = li;
    hipLaunchKernelGGL(mega_fwd, dim3(grid), dim3(NWAVES * 64), LDS_BYTES, stream, a);
    const hipError_t le = hipPeekAtLastError();
    if (le != hipSuccess) fprintf(stderr, "kernel_launch: launch [%d,%d) failed: %s\n", lo, hi, hipGetErrorName(le));
}
extern "C" void kernel_launch(void* const* d_in, const int* in_sizes, int n_in, void* d_out, int out_size, void* d_ws, size_t ws_size, hipStream_t stream) {
    static int grid = 0;
    if (grid == 0) {
        if (n_in != 19 || in_sizes[0] != NLAT * DM || out_size != NLAT * DM || ws_size < WS_END) { fprintf(stderr, "kernel_launch: unexpected shapes (n_in %d, ws %zu); nothing launched\n", n_in, ws_size); grid = -1; return; }
        int dev = 0, cus = 0, per_cu = 0;
        if (hipGetDevice(&dev) != hipSuccess || hipDeviceGetAttribute(&cus, hipDeviceAttributeMultiprocessorCount, dev) != hipSuccess) { grid = -1; return; }
        if (hipFuncSetAttribute((const void*)mega_fwd, hipFuncAttributeMaxDynamicSharedMemorySize, LDS_BYTES) != hipSuccess) { fprintf(stderr, "kernel_launch: hipFuncSetAttribute failed\n"); grid = -1; return; }
        if (hipOccupancyMaxActiveBlocksPerMultiprocessor(&per_cu, (const void*)mega_fwd, NWAVES * 64, LDS_BYTES) != hipSuccess || per_cu < 1) fprintf(stderr, "kernel_launch: occupancy query says %d\n", per_cu);
        (void)hipGetLastError();
        grid = cus;
    }
    if (grid < 0) return;
    (void)hipMemsetAsync((char*)d_ws + WS_CTL, 0, CTL_ZERO_BYTES, stream);
    Args a{};
    for (int i = 0; i < 19; ++i) a.in[i] = (const float*)d_in[i];
    a.out = (float*)d_out; a.ws = (unsigned char*)d_ws;
    unsigned char* ws = (unsigned char*)d_ws; float* out = (float*)d_out; const float* x = a.in[0]; (void)ws; (void)out; (void)x;
    int li = 0;
    for (int k = 0; k < 6;) {
#if MK_MASK != 63
        if (k == 0 && MK_P0SUB != 15) {
            n_prep<<<64, 256, 0, stream>>>(a.in[1], a.in[3], a.in[9], a.in[10], a.in[11], a.in[12], ws);
            n_mod<<<24, 256, 0, stream>>>(a.in[4], a.in[5], ws);
            n_transpose<<<dim3(DIN / 32, DM / 32), dim3(32, 8), 0, stream>>>(a.in[7], DM, DIN, (bf16_t*)(ws + WS_WIN), 2048);
            n_transpose<<<dim3(DM / 32, DM / 32), dim3(32, 8), 0, stream>>>(a.in[8], DM, DM, (bf16_t*)(ws + WS_WOUT), 0);
            n_cvt<<<(NG * CH * CH + 255) / 256, 256, 0, stream>>>(a.in[16], (bf16_t*)(ws + WS_WS), NG * CH * CH); }
#endif
        if ((MK_MASK >> k) & 1) { int e = k + 1; if (MK_JOIN) while (e < 6 && ((MK_MASK >> e) & 1)) ++e; launch_mega(a, k, e, li++, grid, stream); k = e; continue; }
#if MK_MASK != 63
        switch (k) {
        case 0:
            n_prep<<<64, 256, 0, stream>>>(a.in[1], a.in[3], a.in[9], a.in[10], a.in[11], a.in[12], ws);
            n_mod<<<24, 256, 0, stream>>>(a.in[4], a.in[5], ws);
            n_transpose<<<dim3(DIN / 32, DM / 32), dim3(32, 8), 0, stream>>>(a.in[7], DM, DIN, (bf16_t*)(ws + WS_WIN), 2048);
            n_transpose<<<dim3(DM / 32, DM / 32), dim3(32, 8), 0, stream>>>(a.in[8], DM, DM, (bf16_t*)(ws + WS_WOUT), 0);
            n_cvt<<<(NG * CH * CH + 255) / 256, 256, 0, stream>>>(a.in[16], (bf16_t*)(ws + WS_WS), NG * CH * CH); break;
        case 1: n_hrow<<<MTOT, 256, 0, stream>>>(x, a.in[2], a.in[6], ws); break;
        case 2:
            n_gemm<1><<<dim3(DIN / 128, NLAT / 64), 256, 0, stream>>>((const bf16_t*)(ws + WS_H), (const bf16_t*)(ws + WS_WIN), DM, 0, 0, ws, nullptr, nullptr);
            n_gemm<1><<<dim3(2048 / 128, NCTX / 64), 256, 0, stream>>>((const bf16_t*)(ws + WS_H) + (size_t)NLAT * DM, (const bf16_t*)(ws + WS_WIN) + (size_t)1024 * DM, DM, NLAT, 1024, ws, nullptr, nullptr);
            n_vbstat<<<NLAT / 4, 256, 0, stream>>>(ws); break;
        case 3: n_attn<<<NB * NH * SEQ / 2, 128, 0, stream>>>(ws, a.in[13]); n_gate<<<dim3(4, NLAT), 256, 0, stream>>>(ws, a.in[14], a.in[15], a.in[16], a.in[17]); break;
        case 4: n_gemm<2><<<dim3(DM / 128, NLAT / 64), 256, 0, stream>>>((const bf16_t*)(ws + WS_Y), (const bf16_t*)(ws + WS_WOUT), DM, 0, 0, ws, x, out); break;
        default: n_final<<<NLAT, 256, 0, stream>>>(out, a.in[18]); break;
        }
#endif
        ++k;
    }
}
```
